# Optimizing an MI355X kernel written in HIP

```python
import math
import jax
import jax.numpy as jnp
from jax import lax
import numpy as np

D_MODEL = 1024
BATCH = 8
SEQ = 2048
DEPTH = 2

HEAD_DIM = 64
D_MIX = D_MODEL
GROUP_W = D_MIX // 4
Q_BLOCK = 128
EPS = 1e-6
DIL_HEADS = GROUP_W // HEAD_DIM
DILATED_PATTERNS = ((128, 1), (512, 4), (2048, 16))
DIFF_HEADS = 4
DIFF_HEAD_DIM = GROUP_W // (2 * DIFF_HEADS)
SSM_HEADS = GROUP_W // HEAD_DIM
SSM_HEAD_DIM = HEAD_DIM
SSM_GROUPS = 2
SSM_STATE = 128
SSM_CONV = 5
SSM_CHUNK = 128
SSM_XBC = GROUP_W + 2 * SSM_GROUPS * SSM_STATE
NA_HEADS = GROUP_W // HEAD_DIM
GRID_W = 64
NA_WIN_H = 8
NA_WIN_W = 16
PROJ_WIDTHS = (GROUP_W, GROUP_W, GROUP_W, GROUP_W,
               GROUP_W, GROUP_W, GROUP_W, GROUP_W,
               GROUP_W, SSM_XBC, 2 * SSM_HEADS,
               GROUP_W, GROUP_W, GROUP_W, GROUP_W)
D_IN = 13 * GROUP_W + SSM_XBC + 2 * SSM_HEADS

kernel_name = 'hybrid_parallel_group_encoder'


def rms_norm(x, w):
    x32 = x.astype(jnp.float32)
    y = x32 * lax.rsqrt(jnp.mean(x32 * x32, axis=-1, keepdims=True) + EPS)
    return (y * w.astype(jnp.float32)).astype(x.dtype)


def split_cols(t, widths):
    outs = []
    start = 0
    for w in widths:
        outs.append(t[..., start:start + w])
        start += w
    return outs


def to_heads(t, n):
    b, s, _ = t.shape
    return t.reshape(b, s, n, -1).transpose(0, 2, 1, 3)


def to_pair_heads(t):
    b, s, _ = t.shape
    return t.reshape(b, s, DIFF_HEADS, 2, DIFF_HEAD_DIM).transpose(0, 2, 3, 1, 4)


def from_heads(t):
    b, h, s, d = t.shape
    return t.transpose(0, 2, 1, 3).reshape(b, s, h * d)


def alibi_slopes():
    n = DIL_HEADS + DIFF_HEADS
    m = 2.0 ** (-8.0 * jnp.arange(1, n + 1, dtype=jnp.float32) / n)
    return m[0::2], m[1::2]


def dilated_attention(q, k, v, slopes):
    T = q.shape[2]
    scale = q.shape[-1] ** -0.5
    qf, kf, vf = q.astype(jnp.float32), k.astype(jnp.float32), v.astype(jnp.float32)
    pats = []
    for w, r in DILATED_PATTERNS:
        half = w // (2 * r)
        offs = r * np.arange(-half, half + 1)
        pats.append((offs, jnp.asarray(np.abs(offs), jnp.float32)))

    def block(blk):
        t0 = blk * Q_BLOCK
        pos = t0 + jnp.arange(Q_BLOCK)
        qb = lax.dynamic_slice_in_dim(qf, t0, Q_BLOCK, axis=2)
        outs, lses = [], []
        for offs, dist in pats:
            idx = pos[:, None] + offs[None, :]
            valid = (idx >= 0) & (idx < T)
            idx = jnp.clip(idx, 0, T - 1)
            kg = kf[:, :, idx]
            vg = vf[:, :, idx]
            s = jnp.einsum('bhqd,bhqkd->bhqk', qb, kg) * scale - slopes[:, None, None] * dist[None, None, :]
            s = jnp.where(valid[None, None], s, -jnp.inf)
            lse = jax.nn.logsumexp(s, axis=-1)
            outs.append(jnp.einsum('bhqk,bhqkd->bhqd', jnp.exp(s - lse[..., None]), vg))
            lses.append(lse)
        alpha = jax.nn.softmax(jnp.stack(lses), axis=0)
        return jnp.einsum('pbhq,pbhqd->bhqd', alpha, jnp.stack(outs))

    out = lax.map(block, jnp.arange(T // Q_BLOCK))
    return out.transpose(1, 2, 0, 3, 4).reshape(q.shape).astype(q.dtype)


def diff_attention(q, k, v, lam, slopes):
    T = v.shape[2]
    scale = q.shape[-1] ** -0.5
    qf, kf, vf = q.astype(jnp.float32), k.astype(jnp.float32), v.astype(jnp.float32)
    key_pos = jnp.arange(T)

    def block(blk):
        t0 = blk * Q_BLOCK
        pos = t0 + jnp.arange(Q_BLOCK)
        qb = lax.dynamic_slice_in_dim(qf, t0, Q_BLOCK, axis=3)
        bias = -slopes[:, None, None] * jnp.abs(pos[:, None] - key_pos[None, :]).astype(jnp.float32)
        s = jnp.einsum('bhiqd,bhikd->bhiqk', qb, kf) * scale + bias[None, :, None]
        a = jax.nn.softmax(s, axis=-1)
        return jnp.einsum('bhqk,bhkd->bhqd', a[:, :, 0] - lam * a[:, :, 1], vf)

    out = lax.map(block, jnp.arange(T // Q_BLOCK))
    return out.transpose(1, 2, 0, 3, 4).reshape(v.shape).astype(v.dtype)


def segsum(a):
    L = a.shape[-1]
    a_rep = jnp.broadcast_to(a[..., :, None], a.shape + (L,))
    a_rep = jnp.where(jnp.tril(jnp.ones((L, L), bool), -1), a_rep, 0.0)
    cs = jnp.cumsum(a_rep, axis=-2)
    return jnp.where(jnp.tril(jnp.ones((L, L), bool)), cs, -jnp.inf)


def ssd_scan(X, A, Bm, Cm):
    b, T, h, p = X.shape
    nc, l = T // SSM_CHUNK, SSM_CHUNK
    X = X.reshape(b, nc, l, h, p)
    Bm = Bm.reshape(b, nc, l, h, -1)
    Cm = Cm.reshape(b, nc, l, h, -1)
    A = A.reshape(b, nc, l, h).transpose(0, 3, 1, 2)
    A_cum = jnp.cumsum(A, axis=-1)
    Lmat = jnp.exp(segsum(A))
    CB = jnp.einsum('bclhn,bcshn->bhcls', Cm, Bm)
    y_diag = jnp.einsum('bhcls,bcshp->bclhp', CB * Lmat, X)
    decay_states = jnp.exp(A_cum[..., -1:] - A_cum)
    states = jnp.einsum('bclhn,bhcl,bclhp->bchpn', Bm, decay_states, X)
    states = jnp.concatenate([jnp.zeros_like(states[:, :1]), states], axis=1)
    decay_chunk = jnp.exp(segsum(jnp.pad(A_cum[..., -1], ((0, 0), (0, 0), (1, 0)))))
    states = jnp.einsum('bhzc,bchpn->bzhpn', decay_chunk, states)[:, :-1]
    y_off = jnp.einsum('bclhn,bchpn,bhcl->bclhp', Cm, states, jnp.exp(A_cum))
    return (y_diag + y_off).reshape(b, T, h, p)


def ssd_mixer(z, xbc, dt_raw, conv_w, conv_b, a_log, dt_bias, d_skip, norm_w):
    b, T, _ = xbc.shape
    xbc = lax.conv_general_dilated(xbc, conv_w[:, None, :].astype(xbc.dtype), window_strides=(1,),
                                   padding=[(SSM_CONV // 2, SSM_CONV // 2)],
                                   dimension_numbers=('NWC', 'WIO', 'NWC'),
                                   feature_group_count=SSM_XBC) + conv_b
    xbc = jax.nn.silu(xbc).astype(jnp.float32)
    xs, Bm, Cm = split_cols(xbc, (GROUP_W, SSM_GROUPS * SSM_STATE, SSM_GROUPS * SSM_STATE))
    rep = SSM_HEADS // SSM_GROUPS
    xs = xs.reshape(b, T, SSM_HEADS, SSM_HEAD_DIM)
    Bm = jnp.repeat(Bm.reshape(b, T, SSM_GROUPS, SSM_STATE), rep, axis=2)
    Cm = jnp.repeat(Cm.reshape(b, T, SSM_GROUPS, SSM_STATE), rep, axis=2)
    dt = jax.nn.softplus(dt_raw.reshape(b, T, 2, SSM_HEADS).astype(jnp.float32) + dt_bias.astype(jnp.float32))
    A = -jnp.exp(a_log.astype(jnp.float32))
    y_f = ssd_scan(xs * dt[:, :, 0, :, None], A[0] * dt[:, :, 0], Bm, Cm)
    flip = lambda t: jnp.flip(t, axis=1)
    y_b = flip(ssd_scan(flip(xs * dt[:, :, 1, :, None]), flip(A[1] * dt[:, :, 1]), flip(Bm), flip(Cm)))
    y = y_f + y_b + xs * d_skip.astype(jnp.float32)[:, None]
    y = y.reshape(b, T, GROUP_W) * jax.nn.silu(z.astype(jnp.float32))
    yg = y.reshape(b, T, SSM_GROUPS, GROUP_W // SSM_GROUPS)
    yg = yg * lax.rsqrt(jnp.mean(yg * yg, axis=-1, keepdims=True) + EPS)
    return (yg.reshape(b, T, GROUP_W) * norm_w.astype(jnp.float32)).astype(z.dtype)


def neighborhood_attention(q, k, v, rpb):
    b, h, T, d = q.shape
    rows = T // GRID_W
    kh, kw = min(NA_WIN_H, rows), NA_WIN_W
    scale = d ** -0.5
    qg = q.reshape(b, h, rows, GRID_W, d).astype(jnp.float32)
    kg = k.reshape(b, h, rows, GRID_W, d).astype(jnp.float32)
    vg = v.reshape(b, h, rows, GRID_W, d).astype(jnp.float32)
    cols = np.arange(GRID_W)
    col_idx = np.clip(cols - kw // 2, 0, GRID_W - kw)[:, None] + np.arange(kw)[None, :]
    dc = col_idx - cols[:, None] + NA_WIN_W - 1
    rpb = rpb.astype(jnp.float32)

    def row(r):
        rs = jnp.clip(r - kh // 2, 0, rows - kh)
        qr = lax.dynamic_index_in_dim(qg, r, axis=2, keepdims=False)
        kr = lax.dynamic_slice_in_dim(kg, rs, kh, axis=2)[:, :, :, col_idx]
        vr = lax.dynamic_slice_in_dim(vg, rs, kh, axis=2)[:, :, :, col_idx]
        dr = rs + jnp.arange(kh) - r + NA_WIN_H - 1
        bias = rpb[:, dr[None, :, None], dc[:, None, :]]
        s = jnp.einsum('bhqd,bhrqkd->bhqrk', qr, kr) * scale + bias[None]
        p = jax.nn.softmax(s.reshape(b, h, GRID_W, kh * kw), axis=-1).reshape(b, h, GRID_W, kh, kw)
        return jnp.einsum('bhqrk,bhrqkd->bhqd', p, vr)

    out = lax.map(row, jnp.arange(rows))
    return out.transpose(1, 2, 0, 3, 4).reshape(b, h, T, d).astype(q.dtype)


def setup_inputs(seed: int = 0) -> dict:
    key = jax.random.key(seed)
    ks = jax.random.split(key, 17)
    f32 = jnp.float32

    def nrm(k, shape, s):
        return s * jax.random.normal(k, shape, f32)

    x = nrm(ks[0], (BATCH, SEQ, D_MODEL), 1.0)
    c = nrm(ks[1], (BATCH, D_MODEL), 1.0)
    norm_w = 1.0 + nrm(ks[2], (DEPTH, D_MODEL), 0.02)
    ada_w = nrm(ks[3], (DEPTH, D_MODEL, 3 * D_MODEL), D_MODEL ** -0.5)
    ada_b = nrm(ks[4], (DEPTH, 3 * D_MODEL), 0.02)
    w_in = nrm(ks[5], (DEPTH, D_MODEL, D_IN), D_MODEL ** -0.5)
    diff_lambda = nrm(ks[6], (DEPTH, 4, DIFF_HEAD_DIM), 0.1)
    diff_norm_w = 1.0 + nrm(ks[7], (DEPTH, 2 * DIFF_HEAD_DIM), 0.02)
    conv_w = nrm(ks[8], (DEPTH, SSM_CONV, SSM_XBC), SSM_CONV ** -0.5)
    conv_b = nrm(ks[9], (DEPTH, SSM_XBC), 0.02)
    ssm_a_log = jnp.log(jax.random.uniform(ks[10], (DEPTH, 2, SSM_HEADS), f32, 1.0, 16.0))
    dt0 = jnp.exp(jax.random.uniform(ks[11], (DEPTH, 2, SSM_HEADS), f32, math.log(1e-3), math.log(1e-1)))
    ssm_dt_bias = dt0 + jnp.log(-jnp.expm1(-dt0))
    ssm_d = 1.0 + nrm(ks[12], (DEPTH, SSM_HEADS), 0.1)
    ssm_norm_w = 1.0 + nrm(ks[13], (DEPTH, GROUP_W), 0.02)
    na_rpb = nrm(ks[14], (DEPTH, NA_HEADS, 2 * NA_WIN_H - 1, 2 * NA_WIN_W - 1), 0.02)
    w_out = nrm(ks[15], (DEPTH, D_MIX, D_MODEL), D_MIX ** -0.5)
    final_norm_w = 1.0 + nrm(ks[16], (D_MODEL,), 0.02)
    return {'x': x, 'c': c, 'norm_w': norm_w, 'ada_w': ada_w, 'ada_b': ada_b, 'w_in': w_in,
            'diff_lambda': diff_lambda, 'diff_norm_w': diff_norm_w, 'conv_w': conv_w, 'conv_b': conv_b,
            'ssm_a_log': ssm_a_log, 'ssm_dt_bias': ssm_dt_bias, 'ssm_d': ssm_d, 'ssm_norm_w': ssm_norm_w,
            'na_rpb': na_rpb, 'w_out': w_out, 'final_norm_w': final_norm_w}


def reference(x, c, norm_w, ada_w, ada_b, w_in, diff_lambda, diff_norm_w, conv_w, conv_b,
              ssm_a_log, ssm_dt_bias, ssm_d, ssm_norm_w, na_rpb, w_out, final_norm_w):
    slopes_a, slopes_b = alibi_slopes()
    c_act = jax.nn.silu(c)
    for l in range(DEPTH):
        mod = c_act @ ada_w[l] + ada_b[l]
        shift, scale, gate = jnp.split(mod[:, None, :], 3, axis=-1)
        h = rms_norm(x, norm_w[l]) * (1.0 + scale) + shift
        proj = h @ w_in[l]
        (aq, ak, av, ag, bq, bk, bv, bg, cz, cxbc, cdt, dq, dk, dv, dg) = split_cols(proj, PROJ_WIDTHS)
        o_a = dilated_attention(to_heads(aq, DIL_HEADS), to_heads(ak, DIL_HEADS), to_heads(av, DIL_HEADS), slopes_a)
        y_a = from_heads(o_a) * jax.nn.silu(ag)
        lam_init = 0.8 - 0.6 * math.exp(-0.3 * l)
        lv = diff_lambda[l].astype(jnp.float32)
        lam = jnp.exp(jnp.sum(lv[0] * lv[1])) - jnp.exp(jnp.sum(lv[2] * lv[3])) + lam_init
        o_b = diff_attention(to_pair_heads(bq), to_pair_heads(bk), to_heads(bv, DIFF_HEADS), lam, slopes_b)
        o_b = rms_norm(o_b, diff_norm_w[l]) * (1.0 - lam_init)
        y_b = from_heads(o_b) * jax.nn.silu(bg)
        y_c = ssd_mixer(cz, cxbc, cdt, conv_w[l], conv_b[l], ssm_a_log[l], ssm_dt_bias[l], ssm_d[l], ssm_norm_w[l])
        o_d = neighborhood_attention(to_heads(dq, NA_HEADS), to_heads(dk, NA_HEADS), to_heads(dv, NA_HEADS), na_rpb[l])
        y_d = from_heads(o_d) * jax.nn.silu(dg)
        y = jnp.concatenate([y_a, y_b, y_c, y_d], axis=-1) @ w_out[l]
        x = x + gate * y
    return rms_norm(x, final_norm_w)
```

```cpp
#include <hip/hip_runtime.h>
#include <hip/hip_cooperative_groups.h>
#include <cstdio>
#include <cstdint>
namespace cg = cooperative_groups;
namespace pg8 {
#define PG8_LAS __attribute__((address_space(3)))
typedef unsigned short bf16_t;
typedef short bf16x8 __attribute__((ext_vector_type(8)));
typedef float f32x4 __attribute__((ext_vector_type(4)));
typedef unsigned u32x4 __attribute__((ext_vector_type(4)));
constexpr int BM = 256, BK = 64, HALF = 128, HTB = HALF * BK * 2  , STAGE_BYTES = 8 * HTB, NXCD = 8, WGM = 8;

__host__ __device__ __forceinline__ int lds_byte(int r, int c) { const int st = (r >> 4) * 2 + (c >> 5), rr = r & 15, cc = c & 31, ob = rr * 64 + cc * 2; return st * 1024 + (ob ^ (((ob >> 9) & 1) << 5)); }
__host__ __device__ __forceinline__ void stage_rc(int b, int& R, int& C) { const int st = b / 1024, sb = b % 1024, swz = sb ^ (((sb >> 9) & 1) << 5); R = (st >> 1) * 16 + swz / 64; C = (st & 1) * 32 + (swz % 64) / 2; }
__host__ __device__ __forceinline__ int perm32(int rho) { const int n = rho >> 4, i = rho & 15; return 8 * (i >> 2) + 4 * n + (i & 3); }

struct Unit { int pm, pn; };
struct Gemm { const bf16_t* A; const bf16_t* Bt; int M, N, K; };

struct StaticOrder {
    int nM, nN, nwg, G, c;
    __host__ __device__ void init(int M, int N, int G_, int c_) { nM = M / BM; nN = N / BM; nwg = nM * nN; G = G_; c = c_; }
    __host__ __device__ bool next(int i, Unit& u) const {
        const long L = (long)i * G + c; if (L >= nwg) return false;
        int wgid = (int)L; { const int q = nwg / NXCD, r = nwg % NXCD, xcd = wgid % NXCD, off = wgid / NXCD; wgid = (xcd < r ? xcd * (q + 1) : r * (q + 1) + (xcd - r) * q) + off; }
        const int nig = WGM * nN, gid = wgid / nig, fm = gid * WGM, gsz = (nM - fm) < WGM ? (nM - fm) : WGM;
        u.pm = fm + ((wgid % nig) % gsz); u.pn = (wgid % nig) / gsz; return true;
    }
    __device__ __forceinline__ void a_ready(const Unit&) const {}
    __device__ __forceinline__ void done(const Unit&) const {}
};
__device__ __forceinline__ unsigned cvt_pk_bf16(float lo, float hi) { unsigned r; asm volatile("v_cvt_pk_bf16_f32 %0, %1, %2" : "=v"(r) : "v"(lo), "v"(hi)); return r; }
typedef unsigned u32x4e __attribute__((ext_vector_type(4)));
struct EpiProj {
    static constexpr bool PERM = true, AFTER_DRAIN = false;
    bf16_t* O; unsigned* kmax; PG8_LAS unsigned char* epl;
    __device__ __forceinline__ void operator()(const f32x4 (&acc)[2][2][4][2], const Unit& u, int wr, int wc, int fr, int fq) const {
        const int row0 = u.pm * BM + wr * 64 + fr; const int col0 = u.pn * BM + wc * 32 + 8 * fq;
#pragma unroll
        for (int ai = 0; ai < 2; ++ai)
#pragma unroll
            for (int m = 0; m < 4; ++m) {
#pragma unroll
                for (int bj = 0; bj < 2; ++bj) { const f32x4 v0 = acc[ai][bj][m][0], v1 = acc[ai][bj][m][1];
                    u32x4 w; w.x = cvt_pk_bf16(v0[0], v0[1]); w.y = cvt_pk_bf16(v0[2], v0[3]); w.z = cvt_pk_bf16(v1[0], v1[1]); w.w = cvt_pk_bf16(v1[2], v1[3]);
                    PG8_LAS unsigned char* tl = epl + (wr * 4 + wc) * 2048 + ((ai * 4 + m) * 2 + bj) % 2 * 1024;
                    const int ln = fq * 16 + fr;
                    *(PG8_LAS u32x4*)(tl + fr * 64 + ((fq ^ (fr >> 2)) & 3) * 16) = w;
                    const int r2 = ln >> 2, p2 = ln & 3;
                    const u32x4 w2 = *(const PG8_LAS u32x4*)(tl + r2 * 64 + ((p2 ^ (r2 >> 2)) & 3) * 16);
                    const int cc = u.pn * BM + bj * HALF + wc * 32;
                    bf16_t* dst = O + ((size_t)(cc >> 6) * 16384 + (size_t)(u.pm * BM + wr * 64 + ai * HALF + m * 16 + r2)) * 64 + (cc & 63) + p2 * 8;
                    *(u32x4*)dst = w2; } }
        if (u.pn == 1 || u.pn == 5 || u.pn == 13) {
            float mx[2] = {0.f, 0.f};
#pragma unroll
            for (int ai = 0; ai < 2; ++ai)
#pragma unroll
                for (int m = 0; m < 4; ++m)
#pragma unroll
                    for (int bj = 0; bj < 2; ++bj) { const f32x4 v0 = acc[ai][bj][m][0], v1 = acc[ai][bj][m][1];
                        float ss = (v0[0] * v0[0] + v0[1] * v0[1]) + (v0[2] * v0[2] + v0[3] * v0[3]) + (v1[0] * v1[0] + v1[1] * v1[1]) + (v1[2] * v1[2] + v1[3] * v1[3]);
                        ss += __shfl_xor(ss, 16); ss += __shfl_xor(ss, 32); mx[bj] = fmaxf(mx[bj], ss); }
#pragma unroll
            for (int bj = 0; bj < 2; ++bj) {
#pragma unroll
                for (int o = 1; o < 16; o <<= 1) mx[bj] = fmaxf(mx[bj], __shfl_xor(mx[bj], o));
                if (fr == 0 && fq == 0) __hip_atomic_fetch_max(kmax + ((u.pm * BM) >> 11) * 128 + u.pn * 8 + bj * 4 + wc, __builtin_bit_cast(unsigned, mx[bj]), __ATOMIC_RELAXED, __HIP_MEMORY_SCOPE_AGENT); }
        }
    }
};
struct EpiOut {
    static constexpr bool PERM = false, AFTER_DRAIN = false;
    const float* xin; float* xout; const float* modf;
    __device__ __forceinline__ void operator()(const f32x4 (&acc)[2][2][4][2], const Unit& u, int wr, int wc, int fr, int fq) const {
        const int row0 = u.pm * BM + wr * 64 + fr; const int col0 = u.pn * BM + wc * 32 + 4 * fq;
        const int b = (u.pm * BM) >> 11;
        f32x4 gt[2][2];
#pragma unroll
        for (int bj = 0; bj < 2; ++bj)
#pragma unroll
            for (int n = 0; n < 2; ++n) gt[bj][n] = *(const f32x4*)(modf + (size_t)b * 3072 + 2048 + col0 + bj * HALF + 16 * n);
#pragma unroll
        for (int ai = 0; ai < 2; ++ai)
#pragma unroll
            for (int m = 0; m < 4; ++m) { const size_t ro = (size_t)(row0 + ai * HALF + m * 16) * 1024 + col0;
#pragma unroll
                for (int bj = 0; bj < 2; ++bj)
#pragma unroll
                    for (int n = 0; n < 2; ++n) { const size_t o = ro + bj * HALF + 16 * n; const f32x4 xi = *(const f32x4*)(xin + o);
                        *(f32x4*)(xout + o) = xi + gt[bj][n] * acc[ai][bj][m][n]; } }
    }
};
struct EpiOutFin {
    static constexpr bool PERM = false, AFTER_DRAIN = true;
    const float* xin; float* xout; const float* modf; const float* fw; float* xch; unsigned* cnt;
    __device__ __forceinline__ void operator()(const f32x4 (&acc)[2][2][4][2], const Unit& u, int wr, int wc, int fr, int fq) const {}
    __device__ __forceinline__ void fused(f32x4 (&acc)[2][2][4][2], const Unit& u, int wr, int wc, int fr, int fq, PG8_LAS unsigned char* lds, int wid, int lane) const {
        const int row0 = u.pm * BM + wr * 64 + fr; const int col0 = u.pn * BM + wc * 32 + 4 * fq;
        const int b = (u.pm * BM) >> 11;
        PG8_LAS float* P = (PG8_LAS float*)lds; PG8_LAS float* S = P + 1024;
        f32x4 gt[2][2];
#pragma unroll
        for (int bj = 0; bj < 2; ++bj)
#pragma unroll
            for (int n = 0; n < 2; ++n) gt[bj][n] = *(const f32x4*)(modf + (size_t)b * 3072 + 2048 + col0 + bj * HALF + 16 * n);
#pragma unroll
        for (int ai = 0; ai < 2; ++ai)
#pragma unroll
            for (int m = 0; m < 4; ++m) { const size_t ro = (size_t)(row0 + ai * HALF + m * 16) * 1024 + col0; float s = 0.f;
#pragma unroll
                for (int bj = 0; bj < 2; ++bj)
#pragma unroll
                    for (int n = 0; n < 2; ++n) { const f32x4 xi = __builtin_nontemporal_load((const f32x4*)(xin + ro + bj * HALF + 16 * n));
                        const f32x4 v = xi + gt[bj][n] * acc[ai][bj][m][n]; acc[ai][bj][m][n] = v;
                        s += (v[0] * v[0] + v[1] * v[1]) + (v[2] * v[2] + v[3] * v[3]); }
                s += __shfl_xor(s, 16); s += __shfl_xor(s, 32);
                if (fq == 0) P[(ai * HALF + wr * 64 + m * 16 + fr) * 4 + wc] = s; }
        __syncthreads();
        const int t = wid * 64 + lane;
        if (t < 256) { const float rs = (P[t * 4] + P[t * 4 + 1]) + (P[t * 4 + 2] + P[t * 4 + 3]);
            __hip_atomic_store(xch + ((size_t)u.pm * 256 + t) * 4 + u.pn, rs, __ATOMIC_RELAXED, __HIP_MEMORY_SCOPE_AGENT); }
        asm volatile("s_waitcnt vmcnt(0)" ::: "memory");
        __syncthreads();
        if (t == 0) {
            __hip_atomic_fetch_add(cnt + 64 * u.pm, 1u, __ATOMIC_RELAXED, __HIP_MEMORY_SCOPE_AGENT);
            unsigned sp = 0;
            while (__hip_atomic_load(cnt + 64 * u.pm, __ATOMIC_RELAXED, __HIP_MEMORY_SCOPE_AGENT) < 4u) { __builtin_amdgcn_s_sleep(1); if (++sp > (1u << 22)) break; }
        }
        __syncthreads();
        if (t < 256) { float tot = 0.f;
#pragma unroll
            for (int pn2 = 0; pn2 < 4; ++pn2) tot += __hip_atomic_load(xch + ((size_t)u.pm * 256 + t) * 4 + pn2, __ATOMIC_RELAXED, __HIP_MEMORY_SCOPE_AGENT);
            S[t] = rsqrtf(tot * (1.f / 1024.f) + 1e-6f); }
        __syncthreads();
        f32x4 fwv[2][2];
#pragma unroll
        for (int bj = 0; bj < 2; ++bj)
#pragma unroll
            for (int n = 0; n < 2; ++n) fwv[bj][n] = *(const f32x4*)(fw + col0 + bj * HALF + 16 * n);
#pragma unroll
        for (int ai = 0; ai < 2; ++ai)
#pragma unroll
            for (int m = 0; m < 4; ++m) { const float rstd = S[ai * HALF + wr * 64 + m * 16 + fr]; const size_t ro = (size_t)(row0 + ai * HALF + m * 16) * 1024 + col0;
#pragma unroll
                for (int bj = 0; bj < 2; ++bj)
#pragma unroll
                    for (int n = 0; n < 2; ++n) *(f32x4*)(xout + ro + bj * HALF + 16 * n) = acc[ai][bj][m][n] * rstd * fwv[bj][n]; }
        __syncthreads();
    }
};
struct EpiOutMod {
    static constexpr bool PERM = false, AFTER_DRAIN = true;
    const float* xin; float* xout; const float* modf; const float* nw; const float* modf2; bf16_t* Hn; float* xch; unsigned* cnt;
    __device__ __forceinline__ void operator()(const f32x4 (&acc)[2][2][4][2], const Unit& u, int wr, int wc, int fr, int fq) const {}
    __device__ __forceinline__ void fused(f32x4 (&acc)[2][2][4][2], const Unit& u, int wr, int wc, int fr, int fq, PG8_LAS unsigned char* lds, int wid, int lane) const {
        const int row0 = u.pm * BM + wr * 64 + fr; const int col0 = u.pn * BM + wc * 32 + 4 * fq;
        const int b = (u.pm * BM) >> 11;
        PG8_LAS float* P = (PG8_LAS float*)lds; PG8_LAS float* S = P + 1024;
        {
        f32x4 gt[2][2];
#pragma unroll
        for (int bj = 0; bj < 2; ++bj)
#pragma unroll
            for (int n = 0; n < 2; ++n) gt[bj][n] = *(const f32x4*)(modf + (size_t)b * 3072 + 2048 + col0 + bj * HALF + 16 * n);
#pragma unroll
        for (int ai = 0; ai < 2; ++ai)
#pragma unroll
            for (int m = 0; m < 4; ++m) { const size_t ro = (size_t)(row0 + ai * HALF + m * 16) * 1024 + col0; float s = 0.f;
#pragma unroll
                for (int bj = 0; bj < 2; ++bj)
#pragma unroll
                    for (int n = 0; n < 2; ++n) { const f32x4 xi = __builtin_nontemporal_load((const f32x4*)(xin + ro + bj * HALF + 16 * n));
                        const f32x4 v = xi + gt[bj][n] * acc[ai][bj][m][n]; acc[ai][bj][m][n] = v;
                        *(f32x4*)(xout + ro + bj * HALF + 16 * n) = v;
                        s += (v[0] * v[0] + v[1] * v[1]) + (v[2] * v[2] + v[3] * v[3]); }
                s += __shfl_xor(s, 16); s += __shfl_xor(s, 32);
                if (fq == 0) P[(ai * HALF + wr * 64 + m * 16 + fr) * 4 + wc] = s; }
        }
        __syncthreads();
        const int t = wid * 64 + lane;
        if (t < 256) { const float rs = (P[t * 4] + P[t * 4 + 1]) + (P[t * 4 + 2] + P[t * 4 + 3]);
            __hip_atomic_store(xch + ((size_t)u.pm * 256 + t) * 4 + u.pn, rs, __ATOMIC_RELAXED, __HIP_MEMORY_SCOPE_AGENT); }
        asm volatile("s_waitcnt vmcnt(0)" ::: "memory");
        __syncthreads();
        if (t == 0) {
            __hip_atomic_fetch_add(cnt + 64 * u.pm, 1u, __ATOMIC_RELAXED, __HIP_MEMORY_SCOPE_AGENT);
            unsigned sp = 0;
            while (__hip_atomic_load(cnt + 64 * u.pm, __ATOMIC_RELAXED, __HIP_MEMORY_SCOPE_AGENT) < 4u) { __builtin_amdgcn_s_sleep(1); if (++sp > (1u << 22)) break; }
        }
        f32x4 mul[2][2], add[2][2];
#pragma unroll
        for (int bj = 0; bj < 2; ++bj)
#pragma unroll
            for (int n = 0; n < 2; ++n) { const int c = col0 + bj * HALF + 16 * n;
                mul[bj][n] = *(const f32x4*)(nw + c) * (*(const f32x4*)(modf2 + (size_t)b * 3072 + 1024 + c) + 1.f); add[bj][n] = *(const f32x4*)(modf2 + (size_t)b * 3072 + c); }
        __syncthreads();
        if (t < 256) { float tot = 0.f;
#pragma unroll
            for (int pn2 = 0; pn2 < 4; ++pn2) tot += __hip_atomic_load(xch + ((size_t)u.pm * 256 + t) * 4 + pn2, __ATOMIC_RELAXED, __HIP_MEMORY_SCOPE_AGENT);
            S[t] = rsqrtf(tot * (1.f / 1024.f) + 1e-6f); }
        __syncthreads();
#pragma unroll
        for (int ai = 0; ai < 2; ++ai)
#pragma unroll
            for (int m = 0; m < 4; ++m) { const float rstd = S[ai * HALF + wr * 64 + m * 16 + fr]; bf16_t* hp = Hn + (size_t)(row0 + ai * HALF + m * 16) * 1024 + col0;
#pragma unroll
                for (int bj = 0; bj < 2; ++bj) { const f32x4 h0 = acc[ai][bj][m][0] * rstd * mul[bj][0] + add[bj][0], h1 = acc[ai][bj][m][1] * rstd * mul[bj][1] + add[bj][1];
                    typedef unsigned u32x2e __attribute__((ext_vector_type(2)));
                    u32x2e w0, w1; w0.x = cvt_pk_bf16(h0[0], h0[1]); w0.y = cvt_pk_bf16(h0[2], h0[3]); w1.x = cvt_pk_bf16(h1[0], h1[1]); w1.y = cvt_pk_bf16(h1[2], h1[3]);
                    *(u32x2e*)(hp + bj * HALF) = w0; *(u32x2e*)(hp + bj * HALF + 16) = w1; } }
        __syncthreads();
    }
};
template <class Epi, class Sched, bool ALIGN_EPI = false, bool SP2 = false>
__device__ __forceinline__ void gemm_phase(PG8_LAS unsigned char* lds, const Gemm g, const Sched& S, const Epi& E, const int tid) {
    const int wid = __builtin_amdgcn_readfirstlane(tid >> 6), lane = tid & 63, wr = wid >> 2, wc = wid & 3, fr = lane & 15, fq = lane >> 4;
    const int K = g.K, nt = K / BK;
    unsigned voffA[2], voffB[2];
#pragma unroll
    for (int i = 0; i < 2; ++i) { int R, C; stage_rc(tid * 16 + i * 8192, R, C); const int Rb = Epi::PERM ? ((R & ~31) + perm32(R & 31)) : R;
        voffA[i] = (unsigned)(R * K + C) * 2u; voffB[i] = (unsigned)(Rb * K + C) * 2u; }
    const size_t kstep = (size_t)(BK * 2);
    const size_t hstep = (size_t)HALF * K * 2;
    const size_t tstep = 2 * hstep;
    const unsigned ldsw = (unsigned)wid * 1024u;
    const int aoff = lds_byte(wr * 64 + fr, fq * 8), boff = lds_byte(wc * 32 + fr, fq * 8);
#define PG8_SA(b, h) (((b) * 2 + (h)) * HTB)
#define PG8_SB(b, h) ((4 + (b) * 2 + (h)) * HTB)
#define PG8_STAGE(bufoff, gbase, voff) do { _Pragma("unroll") for (int _i = 0; _i < 2; ++_i) \
        __builtin_amdgcn_global_load_lds((const unsigned*)((const char*)(gbase) + (voff)[_i]), (PG8_LAS unsigned*)(lds + (bufoff) + ldsw + _i * 8192), 16, 0, 0); } while (0)
#define PG8_LDA(dst, b, h) do { _Pragma("unroll") for (int m = 0; m < 4; ++m) _Pragma("unroll") for (int k = 0; k < 2; ++k) dst[m][k] = *(const PG8_LAS bf16x8*)(lds + PG8_SA(b, h) + aoff + m * 2048 + k * 1024); } while (0)
#define PG8_LDB(dst, b, h) do { _Pragma("unroll") for (int n = 0; n < 2; ++n) _Pragma("unroll") for (int k = 0; k < 2; ++k) dst[n][k] = *(const PG8_LAS bf16x8*)(lds + PG8_SB(b, h) + boff + n * 2048 + k * 1024); } while (0)
#define PG8_MMA(ai, bj, At, Bt) do { __builtin_amdgcn_s_setprio(1); _Pragma("unroll") for (int m = 0; m < 4; ++m) _Pragma("unroll") for (int n = 0; n < 2; ++n) _Pragma("unroll") for (int k = 0; k < 2; ++k) \
        acc[ai][bj][m][n] = __builtin_amdgcn_mfma_f32_16x16x32_bf16(Bt[n][k], At[m][k], acc[ai][bj][m][n], 0, 0, 0); __builtin_amdgcn_s_setprio(0); } while (0)
#define PG8_WAIT_V(n) asm volatile("s_waitcnt vmcnt(" #n ")" ::: "memory")
#define PG8_WAIT_L(n) asm volatile("s_waitcnt lgkmcnt(" #n ")" ::: "memory")
#define PG8_BAR __builtin_amdgcn_s_barrier()
#define PG8_SCHED __builtin_amdgcn_sched_barrier(0)
    Unit cur, nxt; int ui = 0;
    if (!S.next(0, cur)) return;
    f32x4 acc[2][2][4][2];
#pragma unroll
    for (int a = 0; a < 2; ++a)
#pragma unroll
        for (int b = 0; b < 2; ++b)
#pragma unroll
            for (int m = 0; m < 4; ++m)
#pragma unroll
                for (int n = 0; n < 2; ++n) acc[a][b][m][n] = (f32x4){0.f, 0.f, 0.f, 0.f};
    bf16x8 At[4][2], B0[2][2], B1[2][2];
    const char* cA = (const char*)g.A + (size_t)cur.pm * tstep; const char* cB = (const char*)g.Bt + (size_t)cur.pn * tstep;
    S.a_ready(cur);
    if constexpr (SP2) {
        PG8_STAGE(PG8_SB(0, 0), cB, voffB); PG8_STAGE(PG8_SB(0, 1), cB + hstep, voffB); PG8_STAGE(PG8_SA(0, 0), cA, voffA); PG8_STAGE(PG8_SA(0, 1), cA + hstep, voffA);
        if (wr == 1) PG8_BAR;
        PG8_WAIT_V(2); PG8_BAR;
        PG8_STAGE(PG8_SB(1, 0), cB + kstep, voffB); PG8_STAGE(PG8_SA(1, 0), cA + kstep, voffA); PG8_STAGE(PG8_SB(1, 1), cB + hstep + kstep, voffB);
        PG8_WAIT_V(6); PG8_BAR;
    } else {
        PG8_STAGE(PG8_SB(0, 0), cB, voffB); PG8_STAGE(PG8_SA(0, 0), cA, voffA); PG8_STAGE(PG8_SB(0, 1), cB + hstep, voffB); PG8_STAGE(PG8_SA(0, 1), cA + hstep, voffA);
        if (wr == 1) PG8_BAR;
        PG8_WAIT_V(4); PG8_BAR;
        PG8_STAGE(PG8_SB(1, 0), cB + kstep, voffB); PG8_STAGE(PG8_SA(1, 0), cA + kstep, voffA); PG8_STAGE(PG8_SB(1, 1), cB + hstep + kstep, voffB);
        PG8_WAIT_V(6); PG8_BAR;
    }
    for (;;) {
        const bool has_next = S.next(ui + 1, nxt);
        const char* nA = has_next ? (const char*)g.A + (size_t)nxt.pm * tstep : cA; const char* nB = has_next ? (const char*)g.Bt + (size_t)nxt.pn * tstep : cB;
        for (int t = 0; t < nt; t += 2) {
            const bool last = (t == nt - 2);
            const char* a1 = cA + (size_t)(t + 1) * kstep;
            const char* a2 = last ? nA : cA + (size_t)(t + 2) * kstep; const char* b2 = last ? nB : cB + (size_t)(t + 2) * kstep;
            const char* a3 = a2 + kstep; const char* b3 = b2 + kstep;
            if (last && has_next) S.a_ready(nxt);
            if constexpr (SP2) {
            PG8_LDB(B0, 0, 0); PG8_LDB(B1, 0, 1); PG8_SCHED; PG8_LDA(At, 0, 0); PG8_STAGE(PG8_SA(1, 1), a1 + hstep, voffA);
            PG8_WAIT_V(8); PG8_WAIT_L(0); PG8_BAR; PG8_MMA(0, 0, At, B0); PG8_MMA(0, 1, At, B1); PG8_BAR; PG8_SCHED;
            PG8_LDA(At, 0, 1); PG8_STAGE(PG8_SB(0, 0), b2, voffB); PG8_STAGE(PG8_SB(0, 1), b2 + hstep, voffB); PG8_STAGE(PG8_SA(0, 0), a2, voffA);
            PG8_WAIT_V(8); PG8_WAIT_L(0); PG8_BAR; PG8_MMA(1, 0, At, B0); PG8_MMA(1, 1, At, B1); PG8_BAR; PG8_SCHED;
            PG8_LDB(B0, 1, 0); PG8_LDB(B1, 1, 1); PG8_SCHED; PG8_LDA(At, 1, 0); PG8_STAGE(PG8_SA(0, 1), a2 + hstep, voffA);
            PG8_WAIT_V(8); PG8_WAIT_L(0); PG8_BAR; PG8_MMA(0, 0, At, B0); PG8_MMA(0, 1, At, B1); PG8_BAR; PG8_SCHED;
            PG8_LDA(At, 1, 1); PG8_STAGE(PG8_SB(1, 0), b3, voffB); PG8_STAGE(PG8_SB(1, 1), b3 + hstep, voffB); PG8_STAGE(PG8_SA(1, 0), a3, voffA);
            PG8_WAIT_V(8); PG8_WAIT_L(0); PG8_BAR; PG8_MMA(1, 0, At, B0); PG8_MMA(1, 1, At, B1); PG8_BAR; PG8_SCHED;
            } else {
            PG8_LDB(B0, 0, 0); PG8_SCHED; PG8_LDA(At, 0, 0); PG8_STAGE(PG8_SA(1, 1), a1 + hstep, voffA);
            PG8_WAIT_L(8); PG8_BAR; PG8_WAIT_L(0); PG8_MMA(0, 0, At, B0); PG8_BAR; PG8_SCHED;
            PG8_LDB(B1, 0, 1); PG8_STAGE(PG8_SB(0, 0), b2, voffB);
            PG8_BAR; PG8_WAIT_L(0); PG8_MMA(0, 1, At, B1); PG8_BAR;
            PG8_LDA(At, 0, 1); PG8_STAGE(PG8_SA(0, 0), a2, voffA);
            PG8_BAR; PG8_WAIT_L(0); PG8_MMA(1, 0, At, B0); PG8_BAR; PG8_SCHED;
            PG8_STAGE(PG8_SB(0, 1), b2 + hstep, voffB);
            PG8_WAIT_V(6); PG8_BAR; PG8_MMA(1, 1, At, B1); PG8_BAR;
            PG8_LDB(B0, 1, 0); PG8_SCHED; PG8_LDA(At, 1, 0); PG8_STAGE(PG8_SA(0, 1), a2 + hstep, voffA);
            PG8_WAIT_L(8); PG8_BAR; PG8_WAIT_L(0); PG8_MMA(0, 0, At, B0); PG8_BAR; PG8_SCHED;
            PG8_LDB(B1, 1, 1); PG8_STAGE(PG8_SB(1, 0), b3, voffB);
            PG8_BAR; PG8_WAIT_L(0); PG8_MMA(0, 1, At, B1); PG8_BAR;
            PG8_LDA(At, 1, 1); PG8_STAGE(PG8_SA(1, 0), a3, voffA);
            PG8_BAR; PG8_WAIT_L(0); PG8_MMA(1, 0, At, B0); PG8_BAR; PG8_SCHED;
            PG8_STAGE(PG8_SB(1, 1), b3 + hstep, voffB);
            PG8_WAIT_V(6); PG8_BAR; PG8_MMA(1, 1, At, B1); PG8_BAR;
            }
        }
        if constexpr (ALIGN_EPI) { if (wr == 0) PG8_BAR; }
        if constexpr (!Epi::AFTER_DRAIN) { E(acc, cur, wr, wc, fr, fq); S.done(cur); }
        if (!has_next) break;
#pragma unroll
        for (int a = 0; a < 2; ++a)
#pragma unroll
            for (int b = 0; b < 2; ++b)
#pragma unroll
                for (int m = 0; m < 4; ++m)
#pragma unroll
                    for (int n = 0; n < 2; ++n) acc[a][b][m][n] = (f32x4){0.f, 0.f, 0.f, 0.f};
        cur = nxt; cA = nA; cB = nB; ++ui;
        if constexpr (ALIGN_EPI) { if (wr == 1) PG8_BAR; }
    }
    PG8_WAIT_V(0);
    if constexpr (!ALIGN_EPI) { if (wr == 0) PG8_BAR; }
    PG8_BAR;
    if constexpr (Epi::AFTER_DRAIN) { E.fused(acc, cur, wr, wc, fr, fq, lds, wid, lane); S.done(cur); }
#undef PG8_SA
#undef PG8_SB
#undef PG8_STAGE
#undef PG8_LDA
#undef PG8_LDB
#undef PG8_MMA
#undef PG8_WAIT_V
#undef PG8_WAIT_L
#undef PG8_BAR
#undef PG8_SCHED
}
}
#define DI __device__ __forceinline__
#define LAS __attribute__((address_space(3)))
typedef unsigned short bf16;
typedef float f32x4 __attribute__((ext_vector_type(4)));
typedef float f32x2_t __attribute__((ext_vector_type(2)));
typedef __bf16 bf16x2_t __attribute__((ext_vector_type(2)));
typedef short bf16x8 __attribute__((ext_vector_type(8)));
typedef short s16x4 __attribute__((ext_vector_type(4)));
typedef unsigned u32x4 __attribute__((ext_vector_type(4)));
typedef unsigned u32x2 __attribute__((ext_vector_type(2)));
#define MFMA16(a, b, c) __builtin_amdgcn_mfma_f32_16x16x32_bf16((a), (b), (c), 0, 0, 0)

constexpr int NB = 8, T = 2048, D = 1024, M = NB * T, DIN = 4104, NP = 4096;
constexpr float EPS = 1e-6f, LOG2E = 1.4426950408889634f;
constexpr int C_AQ = 0, C_AK = 256, C_AV = 512, C_AG = 768, C_BQ = 1024, C_BK = 1280, C_BV = 1536, C_BG = 1792,
              C_CZ = 2048, C_CX = 2304, C_DQ = 3072, C_DK = 3328, C_DV = 3584, C_DG = 3840;
constexpr size_t MiB = (size_t)1 << 20;
constexpr size_t WS_WIN = 0, WS_WOUT = 16 * MiB, WS_MODP = 20 * MiB, WS_DT = 22 * MiB, WS_TOT = 23 * MiB, WS_KMAX = 23 * MiB + 256 * 1024, WS_WDT = 23 * MiB + 320 * 1024, WS_XCH = 23 * MiB + 640 * 1024, WS_MODF = 21 * MiB + 512 * 1024, WS_XCH2 = 22 * MiB + 512 * 1024, WS_LPA = 22 * MiB + 768 * 1024, WS_BAR = 23 * MiB + 512 * 1024, WS_H = 24 * MiB,
                 WS_PROJ = 56 * MiB, WS_ST = 184 * MiB, WS_YC = 216 * MiB, WS_END = 248 * MiB;
constexpr int LDS_BYTES = 131072 + 1024 + 16384;
constexpr int IMG_PITCH = 272, IMG_BYTES = 128 * IMG_PITCH;
constexpr int VT_PITCH = 144;

DI unsigned pk2(float lo, float hi) { f32x2_t v = {lo, hi}; bf16x2_t b = __builtin_convertvector(v, bf16x2_t); return __builtin_bit_cast(unsigned, b); }
DI float bflo(unsigned u) { return __builtin_bit_cast(float, u << 16); }
DI float bfhi(unsigned u) { return __builtin_bit_cast(float, u & 0xffff0000u); }
DI float wave_sum(float v) {
#pragma unroll
    for (int o = 1; o < 64; o <<= 1) v += __shfl_xor(v, o);
    return v;
}
DI float silu_f(float x) { return x * __builtin_amdgcn_rcpf(1.f + __expf(-x)); }
DI float ex2(float x) { return __builtin_amdgcn_exp2f(x); }
DI s16x4 vtr(const LAS char* p) { return __builtin_bit_cast(s16x4, __builtin_amdgcn_ds_read_tr16_b64_v4i16((LAS s16x4*)p)); }
DI bf16x8 cat8(s16x4 lo, s16x4 hi) { return __builtin_shufflevector(lo, hi, 0, 1, 2, 3, 4, 5, 6, 7); }
DI bf16x8 pack8(f32x4 a, f32x4 b) { u32x4 w; w.x = pk2(a[0], a[1]); w.y = pk2(a[2], a[3]); w.z = pk2(b[0], b[1]); w.w = pk2(b[2], b[3]); return __builtin_bit_cast(bf16x8, w); }
#define LDS_WAIT() asm volatile("s_waitcnt lgkmcnt(0)" ::: "memory")

DI void p0_transpose_item(const float* W, int ldw, int srccol, float scale, bf16* WT, int k0, LAS float* scr, int lane) {
    f32x4 wv[8];
#pragma unroll
    for (int i = 0; i < 8; ++i) wv[i] = __builtin_nontemporal_load((const f32x4*)(W + (size_t)(k0 + 8 * i + (lane >> 3)) * ldw + srccol + 4 * (lane & 7)));
#pragma unroll
    for (int i = 0; i < 8; ++i) { LAS float* d = scr + (8 * i + (lane >> 3)) * 33 + 4 * (lane & 7);
        d[0] = wv[i][0] * scale; d[1] = wv[i][1] * scale; d[2] = wv[i][2] * scale; d[3] = wv[i][3] * scale; }
    LDS_WAIT();
    const int c = lane & 7;
#pragma unroll
    for (int j = 0; j < 4; ++j) { const int n = (lane >> 3) + 8 * j; const LAS float* s = scr + (8 * c) * 33 + n;
        u32x4 o; o.x = pk2(s[0 * 33], s[1 * 33]); o.y = pk2(s[2 * 33], s[3 * 33]); o.z = pk2(s[4 * 33], s[5 * 33]); o.w = pk2(s[6 * 33], s[7 * 33]);
        *(u32x4*)(WT + (size_t)n * 1024 + k0 + 8 * c) = o; }
    LDS_WAIT();
}
DI void phase0(const float* cvec, const float* ada_w, const float* w_in, const float* w_out, bf16* WIN, bf16* WOUT, float* MODP, float* KMAX, bf16* WDT,
               LAS unsigned char* lds, int tid, int G) {
    const int lane = tid & 63, wave = tid >> 6;
    if (blockIdx.x == 0) for (int i = tid; i < 2 * 8 * 128; i += 512) KMAX[i] = 0.f;
    for (int i = blockIdx.x * 512 + tid; i < 32768; i += G * 512) { const int l = i >> 14, jj = (i >> 10) & 15, col = i & 1023;
        WDT[i] = jj < 8 ? (bf16)(pk2(w_in[((size_t)l * 1024 + col) * DIN + 3072 + jj], 0.f) & 0xffffu) : (bf16)0; }
    LAS float* scr = (LAS float*)(lds + wave * 16384);
    const int gw = blockIdx.x * 8 + wave, NGW = G * 8;
    constexpr int I_IN = 16 * 128, I_OUT = 16 * 32, I_L = I_IN + I_OUT;
    for (int it = gw; it < 2 * I_L; it += NGW) {
        const int l = it / I_L; int r = it - l * I_L;
        if (r < I_IN) {
            const int kb = r >> 7, nb = r & 127, n0 = 32 * nb; const int src = n0 + (n0 >= 3072 ? 8 : 0);
            float sc = 1.f;
            if (n0 < 256) sc = 0.125f * LOG2E; else if (n0 >= 1024 && n0 < 1280) sc = 0.17677669529663687f * LOG2E; else if (n0 >= 3072 && n0 < 3328) sc = 0.125f * LOG2E;
            p0_transpose_item(w_in + (size_t)l * 1024 * DIN, DIN, src, sc, WIN + ((size_t)l * NP + n0) * 1024, 64 * kb, scr, lane);
        } else {
            r -= I_IN; const int kb = r >> 5, nb = r & 31, n0 = 32 * nb;
            p0_transpose_item(w_out + (size_t)l * 1024 * 1024, 1024, n0, 1.f, WOUT + ((size_t)l * 1024 + n0) * 1024, 64 * kb, scr, lane);
        }
    }
    __syncthreads();
    for (int task = blockIdx.x; task < 192; task += G) {
        const int l = task / 96, rem = task % 96, cgp = rem >> 3, ks = rem & 7;
        const float* W = ada_w + (size_t)l * 1024 * 3072;
        const int k0 = ks * 128 + wave * 16, col = cgp * 256 + lane * 4;
        f32x4 acc[8];
#pragma unroll
        for (int b = 0; b < 8; ++b) acc[b] = (f32x4){0.f, 0.f, 0.f, 0.f};
#pragma unroll 4
        for (int kk = 0; kk < 16; ++kk) { const int k = k0 + kk; const f32x4 w = __builtin_nontemporal_load((const f32x4*)(W + (size_t)k * 3072 + col));
#pragma unroll
            for (int b = 0; b < 8; ++b) { const float ca = silu_f(cvec[b * 1024 + k]); acc[b] += w * ca; } }
        LAS float* red = (LAS float*)lds;
#pragma unroll
        for (int b = 0; b < 8; ++b) *(LAS f32x4*)(red + (wave * 8 + b) * 256 + lane * 4) = acc[b];
        __syncthreads();
        { const int idx = tid * 4, b = idx >> 8, cc = idx & 255; f32x4 s = (f32x4){0.f, 0.f, 0.f, 0.f};
#pragma unroll
          for (int w = 0; w < 8; ++w) s += *(const LAS f32x4*)(red + (w * 8 + b) * 256 + cc);
          *(f32x4*)(MODP + ((size_t)(l * 8 + ks) * 8 + b) * 3072 + cgp * 256 + cc) = s; }
        __syncthreads();
    }
}

DI void phase_modulate(const float* xin, const float* norm_w, const float* modp, const float* adab,
                       bf16* H, LAS unsigned char* lds, int tid, int G, float* MODF, const float* MODP_all, const float* adab_all) {
    const int lane = tid & 63, wave = tid >> 6;
    if (MODF) for (int idx = blockIdx.x * 512 + tid; idx < 2 * 8 * 3072; idx += G * 512) { const int l2 = idx / 24576, rem = idx - l2 * 24576, b2 = rem / 3072, c2 = rem - b2 * 3072;
        float v = adab_all[l2 * 3072 + c2];
#pragma unroll
        for (int ks = 0; ks < 8; ++ks) v += MODP_all[((size_t)(l2 * 8 + ks) * 8 + b2) * 3072 + c2];
        MODF[idx] = v; }
    LAS float* sh = (LAS float*)lds; LAS float* sc = sh + 1024;
    __syncthreads();
    f32x4 nw[4];
#pragma unroll
    for (int j = 0; j < 4; ++j) nw[j] = *(const f32x4*)(norm_w + 4 * lane + 256 * j);
    int curb = -1;
    for (int rb = blockIdx.x; rb < 256; rb += G) {
        const int b = rb >> 5;
        if (b != curb) {
            __syncthreads();
            for (int i = tid; i < 2048; i += 512) { float v = adab[i];
#pragma unroll
                for (int ks = 0; ks < 8; ++ks) v += modp[(size_t)(ks * 8 + b) * 3072 + i];
                sh[i] = (i >= 1024) ? 1.f + v : v; }
            curb = b; __syncthreads();
        }
        f32x4 vbuf[3][4];
#pragma unroll
        for (int pre = 0; pre < 2; ++pre) { const f32x4* xr = (const f32x4*)(xin + (size_t)(rb * 64 + wave + 8 * pre) * 1024) + lane;
#pragma unroll
            for (int j = 0; j < 4; ++j) vbuf[pre][j] = __builtin_nontemporal_load(xr + 64 * j); }
#pragma unroll
        for (int it = 0; it < 8; ++it) {
            const int row = rb * 64 + wave + 8 * it;
            if (it + 2 < 8) { const f32x4* xr = (const f32x4*)(xin + (size_t)(row + 16) * 1024) + lane;
#pragma unroll
                for (int j = 0; j < 4; ++j) vbuf[(it + 2) % 3][j] = __builtin_nontemporal_load(xr + 64 * j); }
            f32x4 v[4]; float ss = 0.f;
#pragma unroll
            for (int j = 0; j < 4; ++j) { v[j] = vbuf[it % 3][j]; ss += (v[j][0] * v[j][0] + v[j][1] * v[j][1]) + (v[j][2] * v[j][2] + v[j][3] * v[j][3]); }
            const float rstd = rsqrtf(wave_sum(ss) * (1.f / 1024.f) + EPS);
#pragma unroll
            for (int j = 0; j < 4; ++j) { const int col = 4 * lane + 256 * j;
                const f32x4 shv = *(const LAS f32x4*)(sh + col), scv = *(const LAS f32x4*)(sc + col);
                const f32x4 hv = v[j] * rstd * nw[j] * scv + shv;
                u32x2 o; o.x = pk2(hv[0], hv[1]); o.y = pk2(hv[2], hv[3]);
                *(u32x2*)(H + (size_t)row * 1024 + col) = o; asm volatile("" ::: "memory"); }
        }
    }
    __syncthreads();
}
DI const bf16* slab(const bf16* PROJ, int col64, int b) { return PROJ + ((size_t)(col64 >> 6) * M + (size_t)b * T) * 64; }
DI void rows16_load(LAS char* t, const bf16* base, int pitch, int tok0, int tstride, int lane) {
#pragma unroll
    for (int it = 0; it < 2; ++it) { const int n = lane + 64 * it, row = n >> 3, ch = n & 7;
        *(LAS u32x4*)(t + row * VT_PITCH + ch * 16) = *(const u32x4*)(base + (size_t)(tok0 + tstride * row) * pitch + ch * 8); }
}
DI void rows16_store(const LAS char* t, bf16* base, int pitch, int tok0, int tstride, int lane) {
#pragma unroll
    for (int it = 0; it < 2; ++it) { const int n = lane + 64 * it, row = n >> 3, ch = n & 7;
        *(u32x4*)(base + (size_t)(tok0 + tstride * row) * pitch + ch * 8) = *(const LAS u32x4*)(t + row * VT_PITCH + ch * 16); }
}
constexpr int KV_PITCH = 144, KV_TILE = 128 * KV_PITCH;
DI float sumsq8(bf16x8 v) { const u32x4 u = __builtin_bit_cast(u32x4, v); float s = 0.f;
#pragma unroll
    for (int i = 0; i < 4; ++i) { const float a = bflo(u[i]), b = bfhi(u[i]); s += a * a + b * b; }
    return s; }
struct SBlk { f32x4 a[2][2], b[2][2]; };
DI float alibi_c(float dkf, float pf, float nslope2, float nbound) { float t, c;
    asm("v_add_f32_e32 %0, %1, %2" : "=v"(t) : "s"(dkf), "v"(pf));
    asm("v_fma_f32 %0, |%1|, %2, %3" : "=v"(c) : "v"(t), "s"(nslope2), "v"(nbound));
    return c; }
DI void mixerB2_unit(int u, int l, const bf16* PROJ, bf16* YC, const float* dlam_l, const float* dnw_l, const float* kmax_l, LAS char* lds, int tid, int wave, int lane) {
    const int b = u >> 5, h = (u >> 3) & 3, qb = u & 7, r = lane & 15, g = lane >> 4, q = (lane & 15) >> 2, p = lane & 3;
    const bf16* kbase = slab(PROJ, C_BK + h * 64, b); const bf16* vbase = slab(PROJ, C_BV + h * 64, b);
    const bf16* qbase = slab(PROJ, C_BQ + h * 64, b); const bf16* gbase = slab(PROJ, C_BG + h * 64, b);
    const int q0w = qb * 256 + wave * 32;
    LAS char* Kb = lds; LAS char* Vb = lds + 2 * KV_TILE;
    const float slope2 = ex2(-(float)(2 * h + 2)) * LOG2E;
    __syncthreads();
    bf16x8 q1[2], q2[2]; float bound[2];
    LAS char* qs = lds + 92160 + wave * (32 * KV_PITCH);
#pragma unroll
    for (int qt = 0; qt < 2; ++qt) { const bf16* qp = qbase + (size_t)(q0w + 16 * qt + r) * 64 + 8 * g;
        q1[qt] = *(const bf16x8*)qp; q2[qt] = *(const bf16x8*)(qp + 32);
        *(LAS bf16x8*)(qs + (16 * qt + r) * KV_PITCH + 16 * g) = q1[qt]; *(LAS bf16x8*)(qs + (16 * qt + r) * KV_PITCH + 64 + 16 * g) = q2[qt]; }
    const int lrow = tid >> 3, lch = tid & 7;
    u32x4 rk = *(const u32x4*)(kbase + (size_t)lrow * 64 + lch * 8), rv = *(const u32x4*)(vbase + (size_t)lrow * 64 + lch * 8);
    u32x4 rk2 = *(const u32x4*)(kbase + (size_t)(lrow + 64) * 64 + lch * 8), rv2 = *(const u32x4*)(vbase + (size_t)(lrow + 64) * 64 + lch * 8);
    *(LAS u32x4*)(Kb + lrow * KV_PITCH + lch * 16) = rk; *(LAS u32x4*)(Vb + lrow * KV_PITCH + lch * 16) = rv;
    *(LAS u32x4*)(Kb + (lrow + 64) * KV_PITCH + lch * 16) = rk2; *(LAS u32x4*)(Vb + (lrow + 64) * KV_PITCH + lch * 16) = rv2;
    __syncthreads();
    { const float k1 = kmax_l[b * 128 + 40 + 2 * h], k2 = kmax_l[b * 128 + 41 + 2 * h];
#pragma unroll
      for (int qt = 0; qt < 2; ++qt) { float a = sumsq8(q1[qt]), c = sumsq8(q2[qt]);
          a += __shfl_xor(a, 16); a += __shfl_xor(a, 32); c += __shfl_xor(c, 16); c += __shfl_xor(c, 32);
          bound[qt] = fmaxf(sqrtf(a * k1), sqrtf(c * k2)) * 1.01f + 0.05f; } }
    f32x4 Pf;
#pragma unroll
    for (int i = 0; i < 4; ++i) Pf[i] = (float)(4 * g + i - r);
    const float nslope2s = __builtin_bit_cast(float, __builtin_amdgcn_readfirstlane(__builtin_bit_cast(int, -slope2)));
    float nbound[2] = {-bound[0], -bound[1]};
    f32x4 o1[2][4], o2[2][4], ol1[2], ol2[2];
#pragma unroll
    for (int qt = 0; qt < 2; ++qt) { ol1[qt] = (f32x4){0.f, 0.f, 0.f, 0.f}; ol2[qt] = ol1[qt];
#pragma unroll
        for (int c = 0; c < 4; ++c) { o1[qt][c] = ol1[qt]; o2[qt][c] = ol1[qt]; } }
    const bf16x8 ones = {0x3F80, 0x3F80, 0x3F80, 0x3F80, 0x3F80, 0x3F80, 0x3F80, 0x3F80};
    for (int kt128 = 0; kt128 < 16; ++kt128) {
        {
        const LAS char* K0 = Kb + (kt128 & 1) * KV_TILE; const LAS char* V0 = Vb + (kt128 & 1) * KV_TILE;
#define B_QK(S, hf_, ks_) do { const LAS char* Kc_ = K0 + (hf_) * 64 * KV_PITCH; bf16x8 qa[2], qb2[2]; \
        _Pragma("unroll") for (int qt = 0; qt < 2; ++qt) { qa[qt] = *(const LAS bf16x8*)(qs + (16 * qt + r) * KV_PITCH + 16 * g); qb2[qt] = *(const LAS bf16x8*)(qs + (16 * qt + r) * KV_PITCH + 64 + 16 * g); } \
        _Pragma("unroll") for (int kk = 0; kk < 2; ++kk) { const int kt = 2 * (ks_) + kk; \
            const bf16x8 kf1 = *(const LAS bf16x8*)(Kc_ + (16 * kt + r) * KV_PITCH + 16 * g), kf2 = *(const LAS bf16x8*)(Kc_ + (16 * kt + r) * KV_PITCH + 64 + 16 * g); \
            _Pragma("unroll") for (int qt = 0; qt < 2; ++qt) { const float dkf = (float)(128 * kt128 + 64 * (hf_) + 16 * kt - (q0w + 16 * qt)); f32x4 C; \
                _Pragma("unroll") for (int i = 0; i < 4; ++i) C[i] = alibi_c(dkf, Pf[i], nslope2s, nbound[qt]); \
                S.a[qt][kk] = MFMA16(kf1, qa[qt], C); S.b[qt][kk] = MFMA16(kf2, qb2[qt], C); } } } while (0)
#define B_SMPV(S, hf_, ks_) do { const LAS char* Vc_ = V0 + (hf_) * 64 * KV_PITCH; bf16x8 pf1[2], pf2[2]; \
        _Pragma("unroll") for (int qt = 0; qt < 2; ++qt) { \
            _Pragma("unroll") for (int kk = 0; kk < 2; ++kk) _Pragma("unroll") for (int i = 0; i < 4; ++i) { S.a[qt][kk][i] = ex2(S.a[qt][kk][i]); S.b[qt][kk][i] = ex2(S.b[qt][kk][i]); } \
            pf1[qt] = pack8(S.a[qt][0], S.a[qt][1]); pf2[qt] = pack8(S.b[qt][0], S.b[qt][1]); \
            ol1[qt] = MFMA16(ones, pf1[qt], ol1[qt]); ol2[qt] = MFMA16(ones, pf2[qt], ol2[qt]); } \
        const LAS char* v0 = Vc_ + (32 * (ks_) + 4 * g + q) * KV_PITCH + 8 * p; \
        _Pragma("unroll") for (int c = 0; c < 4; ++c) { const bf16x8 vf = cat8(vtr(v0 + 32 * c), vtr(v0 + 16 * KV_PITCH + 32 * c)); \
            _Pragma("unroll") for (int qt = 0; qt < 2; ++qt) { o1[qt][c] = MFMA16(vf, pf1[qt], o1[qt][c]); o2[qt][c] = MFMA16(vf, pf2[qt], o2[qt][c]); } } \
        __builtin_amdgcn_sched_barrier(0); } while (0)
        SBlk SA, SB;
        B_QK(SA, 0, 0); B_QK(SB, 0, 1);
        B_SMPV(SA, 0, 0);
        if (kt128 + 1 < 16) { const size_t ro = (size_t)(128 * (kt128 + 1) + lrow) * 64 + lch * 8; rk = *(const u32x4*)(kbase + ro); rv = *(const u32x4*)(vbase + ro); }
        B_QK(SA, 1, 0);
        B_SMPV(SB, 0, 1);
        B_QK(SB, 1, 1);
        if (kt128 + 1 < 16) { LAS char* Kn = Kb + ((kt128 + 1) & 1) * KV_TILE; LAS char* Vn = Vb + ((kt128 + 1) & 1) * KV_TILE;
            *(LAS u32x4*)(Kn + lrow * KV_PITCH + lch * 16) = rk; *(LAS u32x4*)(Vn + lrow * KV_PITCH + lch * 16) = rv;
            const size_t ro = (size_t)(128 * (kt128 + 1) + 64 + lrow) * 64 + lch * 8; rk = *(const u32x4*)(kbase + ro); rv = *(const u32x4*)(vbase + ro); }
        B_SMPV(SA, 1, 0);
        B_SMPV(SB, 1, 1);
#undef B_QK
#undef B_SMPV
        }
        if (kt128 + 1 < 16) { LAS char* Kn = Kb + ((kt128 + 1) & 1) * KV_TILE; LAS char* Vn = Vb + ((kt128 + 1) & 1) * KV_TILE;
            *(LAS u32x4*)(Kn + (lrow + 64) * KV_PITCH + lch * 16) = rk; *(LAS u32x4*)(Vn + (lrow + 64) * KV_PITCH + lch * 16) = rv; }
        __syncthreads();
    }
    float pa = 0.f, pb = 0.f;
    if (lane < 32) { pa = dlam_l[lane] * dlam_l[32 + lane]; pb = dlam_l[64 + lane] * dlam_l[96 + lane]; }
    pa = wave_sum(pa); pb = wave_sum(pb);
    const float lam_init = 0.8f - 0.6f * __expf(-0.3f * (float)l);
    const float lam = __expf(pa) - __expf(pb) + lam_init;
    LAS char* sc = lds + 4 * KV_TILE + wave * (16 * VT_PITCH);
#pragma unroll
    for (int qt = 0; qt < 2; ++qt) {
        const int tok0 = q0w + 16 * qt;
        const float i1 = 1.f / ol1[qt][0], i2 = lam / ol2[qt][0];
        f32x4 o[4]; float ss = 0.f;
#pragma unroll
        for (int c = 0; c < 4; ++c) { o[c] = o1[qt][c] * i1 - o2[qt][c] * i2; ss += (o[c][0] * o[c][0] + o[c][1] * o[c][1]) + (o[c][2] * o[c][2] + o[c][3] * o[c][3]); }
        ss += __shfl_xor(ss, 16); ss += __shfl_xor(ss, 32);
        const float rstd = rsqrtf(ss * (1.f / 64.f) + EPS) * (1.f - lam_init);
        rows16_load(sc, gbase, 64, tok0, 1, lane);
        u32x2 gv[4];
#pragma unroll
        for (int c = 0; c < 4; ++c) gv[c] = *(const LAS u32x2*)(sc + r * VT_PITCH + (16 * c + 4 * g) * 2);
#pragma unroll
        for (int c = 0; c < 4; ++c) { const int dd = 16 * c + 4 * g;
            const f32x4 nw = *(const f32x4*)(dnw_l + dd);
            const f32x4 y = o[c] * rstd * nw;
            u32x2 w; w.x = pk2(y[0] * silu_f(bflo(gv[c].x)), y[1] * silu_f(bfhi(gv[c].x))); w.y = pk2(y[2] * silu_f(bflo(gv[c].y)), y[3] * silu_f(bfhi(gv[c].y)));
            *(LAS u32x2*)(sc + r * VT_PITCH + dd * 2) = w; }
        rows16_store(sc, YC + (size_t)b * T * 1024 + 256 + h * 64, 1024, tok0, 1, lane);
    }
}

constexpr int KT_OFF = 32 * VT_PITCH;
struct TileRegs { u32x4 k[4]; u32x4 v[4]; };
DI void tile_load(TileRegs& R, const bf16* kb, const bf16* vb, int tokbase, int stride, int lane) {
#pragma unroll
    for (int it = 0; it < 4; ++it) { const int n = lane + 64 * it, row = n >> 3, ch = n & 7; int tok = tokbase + stride * row; tok = min(max(tok, 0), T - 1);
        R.k[it] = *(const u32x4*)(kb + (size_t)tok * 64 + ch * 8); R.v[it] = *(const u32x4*)(vb + (size_t)tok * 64 + ch * 8); }
}
DI void tile_v_to_lds(const TileRegs& R, LAS char* vt, int lane) {
#pragma unroll
    for (int it = 0; it < 4; ++it) { const int n = lane + 64 * it, row = n >> 3, ch = n & 7;
        *(LAS u32x4*)(vt + row * VT_PITCH + ch * 16) = R.v[it]; *(LAS u32x4*)(vt + KT_OFF + row * VT_PITCH + ch * 16) = R.k[it]; }
}
DI bf16x8 k_frag_at(const LAS char* kt, int t, int ks, int lane) { return *(const LAS bf16x8*)(kt + (16 * t + (lane & 15)) * VT_PITCH + 64 * ks + 16 * (lane >> 4)); }
DI bf16x8 k_frag(const LAS char* vt, int t, int ks, int lane) { return k_frag_at(vt + KT_OFF, t, ks, lane); }
constexpr int SC_OFF = 64 * VT_PITCH;
DI void fb_update(f32x4 (&o)[4], f32x4& ol, const f32x4 st0, const f32x4 st1, const LAS char* vt, int lane) {
    f32x4 p0, p1;
#pragma unroll
    for (int i = 0; i < 4; ++i) { p0[i] = ex2(st0[i]); p1[i] = ex2(st1[i]); }
    const bf16x8 pf = pack8(p0, p1);
    const bf16x8 ones = {0x3F80, 0x3F80, 0x3F80, 0x3F80, 0x3F80, 0x3F80, 0x3F80, 0x3F80};
    ol = MFMA16(ones, pf, ol);
    const int g = lane >> 4, q = (lane & 15) >> 2, p = lane & 3;
    const LAS char* v0 = vt + (4 * g + q) * VT_PITCH + 8 * p;
    const LAS char* v1 = v0 + 16 * VT_PITCH;
#pragma unroll
    for (int c = 0; c < 4; ++c) { const bf16x8 vf = cat8(vtr(v0 + 32 * c), vtr(v1 + 32 * c)); o[c] = MFMA16(vf, pf, o[c]); }
}
DI float q_norm2(const bf16x8 (&qf)[2]) { float a = sumsq8(qf[0]) + sumsq8(qf[1]); a += __shfl_xor(a, 16); a += __shfl_xor(a, 32); return a; }

DI void a_desc(int ti, int a0, int rho, int& tokbase, int& stride, int& maxd) {
    if (ti < 4) { stride = 16; tokbase = rho + 512 * ti; maxd = 1024; }
    else if (ti < 10) { stride = 4; const int m0 = 4 * a0 + (rho >> 2) - 64 + 32 * (ti - 4); tokbase = 4 * m0 + (rho & 3); maxd = 256; }
    else { stride = 1; tokbase = 16 * a0 + rho - 64 + 32 * (ti - 10); maxd = 64; }
}
template <bool EDGE>
DI void a_scores(f32x4 (&st)[2], const LAS char* kt, const bf16x8 (&qf)[2], const f32x4 cinit, int tokbase, int stride, int maxd, int tq, float nslope2, int lane) {
    const int g = lane >> 4;
    const int base0 = tokbase + stride * 4 * g - tq;
#pragma unroll
    for (int t = 0; t < 2; ++t) {
        st[t] = MFMA16(k_frag_at(kt, t, 0, lane), qf[0], cinit); st[t] = MFMA16(k_frag_at(kt, t, 1, lane), qf[1], st[t]);
#pragma unroll
        for (int i = 0; i < 4; ++i) { const int d = base0 + stride * (16 * t + i);
            bool ok = (unsigned)(d + maxd) <= (unsigned)(2 * maxd);
            if (EDGE) ok = ok && ((unsigned)(d + tq) < (unsigned)T);
            const float v = __builtin_fmaf(__builtin_fabsf((float)d), nslope2, st[t][i]);
            st[t][i] = ok ? v : -1e30f; }
    }
}
constexpr int A_V1 = 32 * VT_PITCH, A_K = 64 * VT_PITCH;
DI void a_stage(f32x4 (&st)[2], const TileRegs& R, LAS char* vt, int vpar, const bf16x8 (&qf)[2], const f32x4 cinit, int tokbase, int stride, int maxd, int tq, float nslope2, int lane) {
#pragma unroll
    for (int it = 0; it < 4; ++it) { const int n = lane + 64 * it, row = n >> 3, ch = n & 7;
        *(LAS u32x4*)(vt + vpar * A_V1 + row * VT_PITCH + ch * 16) = R.v[it]; *(LAS u32x4*)(vt + A_K + row * VT_PITCH + ch * 16) = R.k[it]; }
    a_scores<true>(st, vt + A_K, qf, cinit, tokbase, stride, maxd, tq, nslope2, lane);
}
DI void a_compute(f32x4 (&o)[4], f32x4& ol, const TileRegs& R, const bf16x8 (&qf)[2], const f32x4 cinit, int ti, int a0, int rho, int tq, float nslope2, LAS char* vt, int lane) {
    int tokbase, stride, maxd; a_desc(ti, a0, rho, tokbase, stride, maxd);
    tile_v_to_lds(R, vt, lane);
    f32x4 st[2];
    a_scores<true>(st, vt + KT_OFF, qf, cinit, tokbase, stride, maxd, tq, nslope2, lane);
    fb_update(o, ol, st[0], st[1], vt, lane);
    asm volatile("" ::: "memory");
}
DI float a_bound(const bf16x8 (&qf)[2], const float* kmax_l, int b, int h) { return sqrtf(q_norm2(qf) * (kmax_l[b * 128 + 8 + 2 * h] + kmax_l[b * 128 + 9 + 2 * h])) * 1.01f + 0.05f; }
DI void a1_compute(f32x4 (&o)[4], f32x4& ol, const TileRegs& R, const bf16x8 (&qf)[2], const f32x4 cinit, int tokbase, int tq, float nslope2, LAS char* vt, int lane) {
    tile_v_to_lds(R, vt, lane);
    f32x4 st[2];
    a_scores<true>(st, vt + KT_OFF, qf, cinit, tokbase, 1, 64, tq, nslope2, lane);
    fb_update(o, ol, st[0], st[1], vt, lane);
    asm volatile("" ::: "memory");
}
DI void mixerA1_unit(int u, const bf16* PROJ, bf16* YC, float* LPA, const float* kmax_l, LAS char* vt, int wave, int lane) {
    const int b = u >> 6, h = (u >> 4) & 3, qblk = u & 15, r = lane & 15, g = lane >> 4;
    const bf16* kb = slab(PROJ, C_AK + h * 64, b); const bf16* vb = slab(PROJ, C_AV + h * 64, b);
    const int t0 = qblk * 128 + wave * 16, tq = t0 + r;
    bf16x8 qf[2];
#pragma unroll
    for (int ks = 0; ks < 2; ++ks) qf[ks] = *(const bf16x8*)(slab(PROJ, C_AQ + h * 64, b) + (size_t)tq * 64 + 32 * ks + 8 * g);
    const float nslope2 = -ex2(-(float)(2 * h + 1)) * LOG2E;
    const float bound = a_bound(qf, kmax_l, b, h);
    const f32x4 cinit = {-bound, -bound, -bound, -bound};
    f32x4 o[4], ol = {0.f, 0.f, 0.f, 0.f};
#pragma unroll
    for (int c = 0; c < 4; ++c) o[c] = ol;
    TileRegs R0, R1, R2;
    const int tb0 = t0 - 64;
    tile_load(R0, kb, vb, tb0, 1, lane); tile_load(R1, kb, vb, tb0 + 32, 1, lane); tile_load(R2, kb, vb, tb0 + 64, 1, lane);
    f32x4 sA[2], sB[2];
    a_stage(sA, R0, vt, 0, qf, cinit, tb0, 1, 64, tq, nslope2, lane);        tile_load(R0, kb, vb, tb0 + 96, 1, lane);
    a_stage(sB, R1, vt, 1, qf, cinit, tb0 + 32, 1, 64, tq, nslope2, lane);   tile_load(R1, kb, vb, tb0 + 128, 1, lane);
    fb_update(o, ol, sA[0], sA[1], vt, lane);
    a_stage(sA, R2, vt, 0, qf, cinit, tb0 + 64, 1, 64, tq, nslope2, lane);
    fb_update(o, ol, sB[0], sB[1], vt + A_V1, lane);
    a_stage(sB, R0, vt, 1, qf, cinit, tb0 + 96, 1, 64, tq, nslope2, lane);
    fb_update(o, ol, sA[0], sA[1], vt, lane);
    a_stage(sA, R1, vt, 0, qf, cinit, tb0 + 128, 1, 64, tq, nslope2, lane);
    fb_update(o, ol, sB[0], sB[1], vt + A_V1, lane);
    fb_update(o, ol, sA[0], sA[1], vt, lane);
    LAS char* sc = vt + SC_OFF;
#pragma unroll
    for (int c = 0; c < 4; ++c) { u32x2 w; w.x = pk2(o[c][0], o[c][1]); w.y = pk2(o[c][2], o[c][3]);
        *(LAS u32x2*)(sc + r * VT_PITCH + (16 * c + 4 * g) * 2) = w; }
    rows16_store(sc, YC + (size_t)b * T * 1024 + h * 64, 1024, t0, 1, lane);
    if (g == 0) LPA[(size_t)(b * T + tq) * 4 + h] = ol[0];
}
DI void mixerA2_unit(int u, const bf16* PROJ, bf16* YC, const float* LPA, const float* kmax_l, LAS char* vt, int wave, int lane) {
    const int b = u >> 6, h = (u >> 4) & 3, rho = u & 15, a0 = 16 * wave, r = lane & 15, g = lane >> 4;
    const bf16* kb = slab(PROJ, C_AK + h * 64, b); const bf16* vb = slab(PROJ, C_AV + h * 64, b);
    const int tq = 16 * (a0 + r) + rho;
    bf16x8 qf[2];
#pragma unroll
    for (int ks = 0; ks < 2; ++ks) qf[ks] = *(const bf16x8*)(slab(PROJ, C_AQ + h * 64, b) + (size_t)tq * 64 + 32 * ks + 8 * g);
    const float nslope2 = -ex2(-(float)(2 * h + 1)) * LOG2E;
    const float bound = a_bound(qf, kmax_l, b, h);
    const f32x4 cinit = {-bound, -bound, -bound, -bound};
    f32x4 o[4], ol = {0.f, 0.f, 0.f, 0.f};
#pragma unroll
    for (int c = 0; c < 4; ++c) o[c] = ol;
    TileRegs R0, R1, R2;
#define A_LOAD(R, t_) do { int tb_, sd_, md_; a_desc((t_), a0, rho, tb_, sd_, md_); tile_load(R, kb, vb, tb_, sd_, lane); } while (0)
    A_LOAD(R0, 0); A_LOAD(R1, 1); A_LOAD(R2, 2);
    f32x4 sA[2], sB[2];
#define A_STAGE(S, R, t_) do { int tb_, sd_, md_; a_desc((t_), a0, rho, tb_, sd_, md_); a_stage(S, R, vt, (t_) & 1, qf, cinit, tb_, sd_, md_, tq, nslope2, lane); } while (0)
    A_STAGE(sA, R0, 0); A_LOAD(R0, 3);
    A_STAGE(sB, R1, 1); A_LOAD(R1, 4);
    fb_update(o, ol, sA[0], sA[1], vt, lane);
    A_STAGE(sA, R2, 2); A_LOAD(R2, 5);
    fb_update(o, ol, sB[0], sB[1], vt + A_V1, lane);
    A_STAGE(sB, R0, 3); A_LOAD(R0, 6);
    fb_update(o, ol, sA[0], sA[1], vt, lane);
    A_STAGE(sA, R1, 4); A_LOAD(R1, 7);
    fb_update(o, ol, sB[0], sB[1], vt + A_V1, lane);
    A_STAGE(sB, R2, 5); A_LOAD(R2, 8);
    fb_update(o, ol, sA[0], sA[1], vt, lane);
    A_STAGE(sA, R0, 6); A_LOAD(R0, 9);
    fb_update(o, ol, sB[0], sB[1], vt + A_V1, lane);
    A_STAGE(sB, R1, 7);
    fb_update(o, ol, sA[0], sA[1], vt, lane);
    A_STAGE(sA, R2, 8);
    fb_update(o, ol, sB[0], sB[1], vt + A_V1, lane);
    A_STAGE(sB, R0, 9);
    fb_update(o, ol, sA[0], sA[1], vt, lane);
    fb_update(o, ol, sB[0], sB[1], vt + A_V1, lane);
#undef A_STAGE
#undef A_LOAD
    const float inv = 1.f / (ol[0] + LPA[(size_t)(b * T + tq) * 4 + h]);
    LAS char* sc = vt + SC_OFF; const int tok0 = 16 * a0 + rho;
    bf16* ybase = YC + (size_t)b * T * 1024 + h * 64;
    u32x2 pv[4], gv[4];
    rows16_load(sc, ybase, 1024, tok0, 16, lane);
#pragma unroll
    for (int c = 0; c < 4; ++c) pv[c] = *(const LAS u32x2*)(sc + r * VT_PITCH + (16 * c + 4 * g) * 2);
    rows16_load(sc, slab(PROJ, C_AG + h * 64, b), 64, tok0, 16, lane);
#pragma unroll
    for (int c = 0; c < 4; ++c) gv[c] = *(const LAS u32x2*)(sc + r * VT_PITCH + (16 * c + 4 * g) * 2);
#pragma unroll
    for (int c = 0; c < 4; ++c) {
        f32x4 ov = o[c]; ov[0] += bflo(pv[c].x); ov[1] += bfhi(pv[c].x); ov[2] += bflo(pv[c].y); ov[3] += bfhi(pv[c].y); ov = ov * inv;
        u32x2 w; w.x = pk2(ov[0] * silu_f(bflo(gv[c].x)), ov[1] * silu_f(bfhi(gv[c].x))); w.y = pk2(ov[2] * silu_f(bflo(gv[c].y)), ov[3] * silu_f(bfhi(gv[c].y)));
        *(LAS u32x2*)(sc + r * VT_PITCH + (16 * c + 4 * g) * 2) = w; }
    rows16_store(sc, ybase, 1024, tok0, 16, lane);
}
DI void d_compute(f32x4 (&o)[4], f32x4& ol, const TileRegs& R, const bf16x8 (&qf)[2], const f32x4 cinit, int kr, int kc0, const LAS float* rpl, LAS char* vt, int lane) {
    tile_v_to_lds(R, vt, lane);
    const LAS float* rr_ = rpl + kr * 31;
    f32x4 st[2];
#pragma unroll
    for (int t = 0; t < 2; ++t) {
        st[t] = MFMA16(k_frag(vt, t, 0, lane), qf[0], cinit); st[t] = MFMA16(k_frag(vt, t, 1, lane), qf[1], st[t]);
#pragma unroll
        for (int i = 0; i < 4; ++i) { const bool ok = (unsigned)(kc0 + 16 * t + i) <= 15u;
            const float v = st[t][i] + rr_[16 * t + i];
            st[t][i] = ok ? v : -1e30f; }
    }
    fb_update(o, ol, st[0], st[1], vt, lane);
    asm volatile("" ::: "memory");
}
DI float d_stage_rpb(const float* rpb_l, int h, LAS char* vt, int lane) {
    LAS float* rp = (LAS float*)(vt + 12288); float rmax = 0.f;
    for (int i = lane; i < 15 * 31; i += 64) { const float v = rpb_l[h * 465 + i] * LOG2E; rp[i] = v; rmax = fmaxf(rmax, fabsf(v)); }
#pragma unroll
    for (int o_ = 1; o_ < 64; o_ <<= 1) rmax = fmaxf(rmax, __shfl_xor(rmax, o_));
    return rmax;
}
DI void mixerD2_unit(int u, const bf16* PROJ, bf16* YC, float rmax, const float* kmax_l, LAS char* vt, int wave, int lane) {
    const int b = u >> 6, h = (u >> 4) & 3, wu = (u & 15) * 8 + wave, rr = wu >> 2, cb = wu & 3, r = lane & 15, g = lane >> 4;
    const bf16* kb = slab(PROJ, C_DK + h * 64, b); const bf16* vb = slab(PROJ, C_DV + h * 64, b);
    const int qcol = 16 * cb + r, tq = 64 * rr + qcol;
    const int cs = min(max(qcol - 8, 0), 48), rs = min(max(rr - 4, 0), 24), c0 = min(max(16 * cb - 8, 0), 32);
    LAS float* rp = (LAS float*)(vt + 12288);
    bf16x8 qf[2];
#pragma unroll
    for (int ks = 0; ks < 2; ++ks) qf[ks] = *(const bf16x8*)(slab(PROJ, C_DQ + h * 64, b) + (size_t)tq * 64 + 32 * ks + 8 * g);
    const float bound = sqrtf(q_norm2(qf) * (kmax_l[b * 128 + 104 + 2 * h] + kmax_l[b * 128 + 105 + 2 * h])) * 1.01f + 0.05f + rmax;
    const f32x4 cinit = {-bound, -bound, -bound, -bound};
    f32x4 o[4], ol = {0.f, 0.f, 0.f, 0.f};
#pragma unroll
    for (int c = 0; c < 4; ++c) o[c] = ol;
    const int tb0 = 64 * rs + c0, dr0 = rs - rr + 7;
    const int kc0 = c0 + 4 * g - cs;
    const LAS float* rpl = rp + dr0 * 31 + (c0 + 4 * g - qcol + 15);
    TileRegs R0, R1, R2;
    tile_load(R0, kb, vb, tb0, 1, lane); tile_load(R1, kb, vb, tb0 + 64, 1, lane); tile_load(R2, kb, vb, tb0 + 128, 1, lane);
    d_compute(o, ol, R0, qf, cinit, 0, kc0, rpl, vt, lane); tile_load(R0, kb, vb, tb0 + 192, 1, lane);
    d_compute(o, ol, R1, qf, cinit, 1, kc0, rpl, vt, lane); tile_load(R1, kb, vb, tb0 + 256, 1, lane);
    d_compute(o, ol, R2, qf, cinit, 2, kc0, rpl, vt, lane); tile_load(R2, kb, vb, tb0 + 320, 1, lane);
    d_compute(o, ol, R0, qf, cinit, 3, kc0, rpl, vt, lane); tile_load(R0, kb, vb, tb0 + 384, 1, lane);
    d_compute(o, ol, R1, qf, cinit, 4, kc0, rpl, vt, lane); tile_load(R1, kb, vb, tb0 + 448, 1, lane);
    d_compute(o, ol, R2, qf, cinit, 5, kc0, rpl, vt, lane);
    d_compute(o, ol, R0, qf, cinit, 6, kc0, rpl, vt, lane);
    d_compute(o, ol, R1, qf, cinit, 7, kc0, rpl, vt, lane);
    const float inv = 1.f / ol[0];
    LAS char* sc = vt + SC_OFF; const int tok0 = 64 * rr + 16 * cb;
    u32x2 gv[4];
    rows16_load(sc, slab(PROJ, C_DG + h * 64, b), 64, tok0, 1, lane);
#pragma unroll
    for (int c = 0; c < 4; ++c) gv[c] = *(const LAS u32x2*)(sc + r * VT_PITCH + (16 * c + 4 * g) * 2);
#pragma unroll
    for (int c = 0; c < 4; ++c) { const f32x4 ov = o[c] * inv;
        u32x2 w; w.x = pk2(ov[0] * silu_f(bflo(gv[c].x)), ov[1] * silu_f(bfhi(gv[c].x))); w.y = pk2(ov[2] * silu_f(bflo(gv[c].y)), ov[3] * silu_f(bfhi(gv[c].y)));
        *(LAS u32x2*)(sc + r * VT_PITCH + (16 * c + 4 * g) * 2) = w; }
    rows16_store(sc, YC + (size_t)b * T * 1024 + 768 + h * 64, 1024, tok0, 1, lane);
}
DI void conv_image(LAS char* img, const bf16* PROJ, int b, int t0, int chan0, const float* cw, const float* cb, int item) {
    const int cgp = item & 15, tg = item >> 4, ch = chan0 + cgp * 8, tb = t0 + tg * 8;
    const bf16* base = slab(PROJ, (C_CX + ch) & ~63, b) + ((C_CX + ch) & 63);
    float w[5][8], o[8][8];
#pragma unroll
    for (int k = 0; k < 5; ++k) { const f32x4 a = *(const f32x4*)(cw + k * 768 + ch), c = *(const f32x4*)(cw + k * 768 + ch + 4);
#pragma unroll
        for (int e = 0; e < 4; ++e) { w[k][e] = a[e]; w[k][4 + e] = c[e]; } }
    { const f32x4 a = *(const f32x4*)(cb + ch), c = *(const f32x4*)(cb + ch + 4);
#pragma unroll
      for (int oi = 0; oi < 8; ++oi)
#pragma unroll
          for (int e = 0; e < 4; ++e) { o[oi][e] = a[e]; o[oi][4 + e] = c[e]; } }
#pragma unroll
    for (int ri = 0; ri < 12; ++ri) {
        const int t = tb - 2 + ri;
        u32x4 v = (u32x4){0u, 0u, 0u, 0u};
        if (t >= 0 && t < T) v = *(const u32x4*)(base + (size_t)t * 64);
        float in[8] = {bflo(v.x), bfhi(v.x), bflo(v.y), bfhi(v.y), bflo(v.z), bfhi(v.z), bflo(v.w), bfhi(v.w)};
#pragma unroll
        for (int k = 0; k < 5; ++k) { const int oi = ri - k;
            if (oi >= 0 && oi < 8) {
#pragma unroll
                for (int e = 0; e < 8; ++e) o[oi][e] += w[k][e] * in[e]; } }
    }
#pragma unroll
    for (int oi = 0; oi < 8; ++oi) { u32x4 pk; pk.x = pk2(silu_f(o[oi][0]), silu_f(o[oi][1])); pk.y = pk2(silu_f(o[oi][2]), silu_f(o[oi][3]));
        pk.z = pk2(silu_f(o[oi][4]), silu_f(o[oi][5])); pk.w = pk2(silu_f(o[oi][6]), silu_f(o[oi][7]));
        *(LAS u32x4*)(img + (tg * 8 + oi) * IMG_PITCH + cgp * 16) = pk; }
}
template <bool AUXW>
DI void decay_tables(LAS float* gtab, LAS float* aux, const float* DT, const float* a_log_l, float* TOT, int b, int c, int grp, int combo, int lane) {
    const int hh = combo >> 1, dir = combo & 1, h = 2 * grp + hh;
    const float A = -__expf(a_log_l[dir * 4 + h]);
    const size_t row = (size_t)b * T + c * 128 + 2 * lane;
    const float dt0 = DT[row * 8 + dir * 4 + h], dt1 = DT[(row + 1) * 8 + dir * 4 + h];
    const float a0 = A * dt0, a1 = A * dt1;
    float s = a0 + a1;
#pragma unroll
    for (int o = 1; o < 64; o <<= 1) { const float v = __shfl_up(s, o); if (lane >= o) s += v; }
    const float tot = __shfl(s, 63);
    float g0, g1;
    if (dir == 0) { g1 = s; g0 = s - a1; } else { g0 = tot - (s - a1) + a0; g1 = tot - s + a1; }
    gtab[combo * 128 + 2 * lane] = g0; gtab[combo * 128 + 2 * lane + 1] = g1;
    if (AUXW) { aux[combo * 128 + 2 * lane] = dt0 * __expf(tot - g0); aux[combo * 128 + 2 * lane + 1] = dt1 * __expf(tot - g1);
        if (lane == 0) TOT[((b * 16 + c) * 4 + h) * 2 + dir] = tot; }
    else { aux[combo * 128 + 2 * lane] = dt0; aux[combo * 128 + 2 * lane + 1] = dt1; }
}
DI void ssd_part1_unit(int u, const bf16* PROJ, float* DT, const bf16* H, const bf16* wdtb_l, const float* dt_bias_l, const float* cw, const float* cb, const float* a_log_l, float* STATES, float* TOT,
                       LAS unsigned char* ldsu, int tid, int wave, int lane) {
    const int b = u >> 5, c = (u >> 1) & 15, grp = u & 1, t0 = c * 128;
    LAS char* lds = (LAS char*)ldsu;
    LAS char* XS = lds; LAS char* BM = lds + IMG_BYTES;
    LAS float* gtab = (LAS float*)(lds + 3 * IMG_BYTES); LAS float* wtab = gtab + 512;
    const int r = lane & 15, g = lane >> 4, q = (lane & 15) >> 2, p = lane & 3;
    __syncthreads();
    {
        LAS char* wl = lds + 3 * IMG_BYTES + 4096;
        LAS char* hst = lds + 2 * IMG_BYTES + wave * (16 * IMG_PITCH);
        for (int i = tid; i < 1024; i += 512) { const int row = i >> 7, ch = i & 127; *(LAS u32x4*)(wl + row * 2064 + ch * 16) = *(const u32x4*)(wdtb_l + (size_t)row * 1024 + ch * 8); }
        __syncthreads();
        f32x4 dacc = {0.f, 0.f, 0.f, 0.f};
        const bf16* hrow = H + (size_t)(b * T + t0 + 16 * wave) * 1024;
        u32x4 hv[4];
#pragma unroll
        for (int it = 0; it < 4; ++it) { const int n = lane + 64 * it; hv[it] = *(const u32x4*)(hrow + (size_t)(n >> 4) * 1024 + (n & 15) * 8); }
        for (int ck = 0; ck < 8; ++ck) {
#pragma unroll
            for (int it = 0; it < 4; ++it) { const int n = lane + 64 * it; *(LAS u32x4*)(hst + (n >> 4) * IMG_PITCH + (n & 15) * 16) = hv[it]; }
            if (ck + 1 < 8) {
#pragma unroll
                for (int it = 0; it < 4; ++it) { const int n = lane + 64 * it; hv[it] = *(const u32x4*)(hrow + (size_t)(n >> 4) * 1024 + (ck + 1) * 128 + (n & 15) * 8); } }
#pragma unroll
            for (int ks = 0; ks < 4; ++ks) {
                const bf16x8 af = *(const LAS bf16x8*)(hst + r * IMG_PITCH + 64 * ks + 16 * g);
                bf16x8 bfw = {0, 0, 0, 0, 0, 0, 0, 0};
                if (r < 8) bfw = *(const LAS bf16x8*)(wl + r * 2064 + (ck * 128 + 32 * ks + 8 * g) * 2);
                dacc = MFMA16(af, bfw, dacc);
            }
            asm volatile("" ::: "memory");
        }
        if (r < 8) { const float bias = dt_bias_l[r];
#pragma unroll
            for (int i = 0; i < 4; ++i) { const float xx = dacc[i] + bias; DT[(size_t)(b * T + t0 + 16 * wave + 4 * g + i) * 8 + r] = xx > 20.f ? xx : log1pf(__expf(xx)); } }
    }
    __syncthreads();
    { const int img = tid >> 8; conv_image(img ? BM : XS, PROJ, b, t0, img ? 256 + grp * 128 : grp * 128, cw, cb, tid & 255); }
    asm volatile("s_waitcnt vmcnt(0)" ::: "memory");
    __syncthreads();
    if (wave < 4) decay_tables<true>(gtab, wtab, DT, a_log_l, TOT, b, c, grp, wave, lane);
    __syncthreads();
    bf16x8 bfr[4];
#pragma unroll
    for (int ks = 0; ks < 4; ++ks) { const LAS char* bp = BM + (32 * ks + 8 * g + q) * IMG_PITCH + 32 * wave + 8 * p; bfr[ks] = cat8(vtr(bp), vtr(bp + 4 * IMG_PITCH)); }
#pragma unroll
    for (int combo = 0; combo < 4; ++combo) {
        const int hh = combo >> 1, dir = combo & 1, h = 2 * grp + hh;
        f32x4 acc[4];
#pragma unroll
        for (int pt = 0; pt < 4; ++pt) acc[pt] = (f32x4){0.f, 0.f, 0.f, 0.f};
#pragma unroll
        for (int ks = 0; ks < 4; ++ks) {
            const f32x4 w0 = *(const LAS f32x4*)(wtab + combo * 128 + 32 * ks + 8 * g), w1 = *(const LAS f32x4*)(wtab + combo * 128 + 32 * ks + 8 * g + 4);
#pragma unroll
            for (int pt = 0; pt < 4; ++pt) {
                const LAS char* xp = XS + (32 * ks + 8 * g + q) * IMG_PITCH + (hh * 64 + 16 * pt) * 2 + 8 * p;
                const u32x2 lo = __builtin_bit_cast(u32x2, vtr(xp)), hi = __builtin_bit_cast(u32x2, vtr(xp + 4 * IMG_PITCH));
                u32x4 af; af.x = pk2(bflo(lo.x) * w0[0], bfhi(lo.x) * w0[1]); af.y = pk2(bflo(lo.y) * w0[2], bfhi(lo.y) * w0[3]);
                af.z = pk2(bflo(hi.x) * w1[0], bfhi(hi.x) * w1[1]); af.w = pk2(bflo(hi.y) * w1[2], bfhi(hi.y) * w1[3]);
                acc[pt] = MFMA16(__builtin_bit_cast(bf16x8, af), bfr[ks], acc[pt]);
            }
        }
        float* sb = STATES + ((size_t)(((b * 16 + c) * 4 + h) * 2 + dir) * 64) * 128;
#pragma unroll
        for (int pt = 0; pt < 4; ++pt)
#pragma unroll
            for (int i = 0; i < 4; ++i) sb[(size_t)(16 * pt + 4 * g + i) * 128 + 16 * wave + r] = acc[pt][i];
    }
}
DI void ssd_scan(float* STATES, const float* TOT, int gtid, int gthreads) {
    for (int it = gtid; it < 8 * 4 * 2 * 64 * 32; it += gthreads) {
        const int n4 = it & 31, p = (it >> 5) & 63, dir = (it >> 11) & 1, h = (it >> 12) & 3, b = it >> 14;
        f32x4 v[16]; float e[16];
#pragma unroll
        for (int st = 0; st < 16; ++st) { const int c = dir ? 15 - st : st; const int hd = ((b * 16 + c) * 4 + h) * 2 + dir;
            v[st] = __builtin_nontemporal_load((const f32x4*)(STATES + ((size_t)hd * 64 + p) * 128 + n4 * 4)); e[st] = __expf(TOT[hd]); }
        f32x4 carry = (f32x4){0.f, 0.f, 0.f, 0.f};
#pragma unroll
        for (int st = 0; st < 16; ++st) { const int c = dir ? 15 - st : st; const int hd = ((b * 16 + c) * 4 + h) * 2 + dir;
            *(f32x4*)(STATES + ((size_t)hd * 64 + p) * 128 + n4 * 4) = carry; carry = carry * e[st] + v[st]; }
    }
}
DI void ssd_part2_unit(int u, const bf16* PROJ, const float* DT, const float* cw, const float* cb, const float* a_log_l, const float* dskip_l, const float* snw_l,
                       const float* STATES, bf16* YC, LAS unsigned char* ldsu, int tid, int wave, int lane) {
    const int b = u >> 5, c = (u >> 1) & 15, grp = u & 1, t0 = c * 128;
    LAS char* lds = (LAS char*)ldsu;
    LAS char* XS = lds; LAS char* BM = lds + IMG_BYTES; LAS char* CM = lds + 2 * IMG_BYTES;
    LAS float* gtab = (LAS float*)(lds + 3 * IMG_BYTES); LAS float* dttab = gtab + 512;
    __syncthreads();
    if (tid < 256) conv_image(CM, PROJ, b, t0, 512 + grp * 128, cw, cb, tid);
    if (wave >= 4) decay_tables<false>(gtab, dttab, DT, a_log_l, nullptr, b, c, grp, wave - 4, lane);
#pragma unroll 4
    for (int k = 0; k < 16; ++k) { const int idx = tid + 512 * k, combo = idx >> 11, within = idx & 2047, pp = within >> 5, n4 = within & 31;
        const int hh = combo >> 1, dir = combo & 1, h = 2 * grp + hh;
        const f32x4 sv = __builtin_nontemporal_load((const f32x4*)(STATES + ((size_t)(((b * 16 + c) * 4 + h) * 2 + dir) * 64 + pp) * 128 + n4 * 4));
        u32x2 w; w.x = pk2(sv[0], sv[1]); w.y = pk2(sv[2], sv[3]);
        *(LAS u32x2*)(lds + combo * (64 * IMG_PITCH) + pp * IMG_PITCH + n4 * 8) = w; }
    __syncthreads();
    const int r = lane & 15, g = lane >> 4, q = (lane & 15) >> 2, p = lane & 3;
    const int l0 = 16 * wave, lq = l0 + r;
    bf16x8 cq[4];
#pragma unroll
    for (int ks = 0; ks < 4; ++ks) cq[ks] = *(const LAS bf16x8*)(CM + lq * IMG_PITCH + 64 * ks + 16 * g);
    f32x4 acc[2][4];
#pragma unroll
    for (int hh = 0; hh < 2; ++hh)
#pragma unroll
        for (int pt = 0; pt < 4; ++pt) acc[hh][pt] = (f32x4){0.f, 0.f, 0.f, 0.f};
#pragma unroll
    for (int combo = 0; combo < 4; ++combo) {
        const int hh = combo >> 1;
        const float eg = __expf(gtab[combo * 128 + lq]);
#pragma unroll
        for (int pt = 0; pt < 4; ++pt) {
            f32x4 tmp = (f32x4){0.f, 0.f, 0.f, 0.f};
#pragma unroll
            for (int ks = 0; ks < 4; ++ks) { const bf16x8 af = *(const LAS bf16x8*)(lds + combo * (64 * IMG_PITCH) + (16 * pt + r) * IMG_PITCH + 64 * ks + 16 * g); tmp = MFMA16(af, cq[ks], tmp); }
            acc[hh][pt] += tmp * eg;
        }
    }
    __syncthreads();
    { const int img = tid >> 8; conv_image(lds + img * IMG_BYTES, PROJ, b, t0, img * 256 + grp * 128, cw, cb, tid & 255); }
    __syncthreads();
    for (int st = 0; st < 4; ++st) {
        f32x4 gt[2];
#pragma unroll
        for (int t = 0; t < 2; ++t) { gt[t] = (f32x4){0.f, 0.f, 0.f, 0.f};
#pragma unroll
            for (int ks = 0; ks < 4; ++ks) { const bf16x8 bf = *(const LAS bf16x8*)(BM + (32 * st + 16 * t + r) * IMG_PITCH + 64 * ks + 16 * g); gt[t] = MFMA16(bf, cq[ks], gt[t]); } }
#pragma unroll
        for (int combo = 0; combo < 4; ++combo) {
            const int hh = combo >> 1, dir = combo & 1;
            const bool need = dir == 0 ? (32 * st <= l0 + 15) : (32 * st + 31 >= l0);
            if (need) {
                const float gl = gtab[combo * 128 + lq];
                f32x4 mm[2];
#pragma unroll
                for (int t = 0; t < 2; ++t) { const int sbase = 32 * st + 16 * t + 4 * g;
                    const f32x4 gs = *(const LAS f32x4*)(gtab + combo * 128 + sbase), ds = *(const LAS f32x4*)(dttab + combo * 128 + sbase);
#pragma unroll
                    for (int i = 0; i < 4; ++i) { const int se = sbase + i; const bool ok = dir == 0 ? (se <= lq) : (se >= lq);
                        const float e = __expf(fminf(gl - gs[i], 0.f)); mm[t][i] = ok ? gt[t][i] * e * ds[i] : 0.f; } }
                const bf16x8 pf = pack8(mm[0], mm[1]);
#pragma unroll
                for (int pt = 0; pt < 4; ++pt) { const LAS char* xp = XS + (32 * st + 4 * g + q) * IMG_PITCH + (hh * 64 + 16 * pt) * 2 + 8 * p;
                    acc[hh][pt] = MFMA16(cat8(vtr(xp), vtr(xp + 16 * IMG_PITCH)), pf, acc[hh][pt]); }
            }
        }
    }
    const int token = t0 + lq; float ss = 0.f;
#pragma unroll
    for (int hh = 0; hh < 2; ++hh) { const float dsk = dskip_l[2 * grp + hh];
#pragma unroll
        for (int pt = 0; pt < 4; ++pt) { const int ch = hh * 64 + 16 * pt + 4 * g;
            const u32x2 xv = *(const LAS u32x2*)(XS + lq * IMG_PITCH + ch * 2);
            const u32x2 zv = *(const u32x2*)(slab(PROJ, C_CZ + grp * 128 + hh * 64, b) + (size_t)token * 64 + 16 * pt + 4 * g);
            f32x4 y = acc[hh][pt];
            y[0] = (y[0] + dsk * bflo(xv.x)) * silu_f(bflo(zv.x)); y[1] = (y[1] + dsk * bfhi(xv.x)) * silu_f(bfhi(zv.x));
            y[2] = (y[2] + dsk * bflo(xv.y)) * silu_f(bflo(zv.y)); y[3] = (y[3] + dsk * bfhi(xv.y)) * silu_f(bfhi(zv.y));
            acc[hh][pt] = y; ss += (y[0] * y[0] + y[1] * y[1]) + (y[2] * y[2] + y[3] * y[3]); } }
    ss += __shfl_xor(ss, 16); ss += __shfl_xor(ss, 32);
    const float rstd = rsqrtf(ss * (1.f / 128.f) + EPS);
#pragma unroll
    for (int hh = 0; hh < 2; ++hh)
#pragma unroll
        for (int pt = 0; pt < 4; ++pt) { const int ch = grp * 128 + hh * 64 + 16 * pt + 4 * g;
            const f32x4 nw = *(const f32x4*)(snw_l + ch); const f32x4 y = acc[hh][pt] * rstd * nw;
            u32x2 w; w.x = pk2(y[0], y[1]); w.y = pk2(y[2], y[3]);
            *(u32x2*)(YC + (size_t)(b * T + token) * 1024 + 512 + ch) = w; }
}

DI void phase_final(float* xo, const float* fw, int tid, int G) {
    const int lane = tid & 63, wave = tid >> 6;
    f32x4 nw[4];
#pragma unroll
    for (int j = 0; j < 4; ++j) nw[j] = *(const f32x4*)(fw + 4 * lane + 256 * j);
    const int stride = G * 8, nrow = (M - (blockIdx.x * 8 + wave) + stride - 1) / stride;
    const int row0 = blockIdx.x * 8 + wave;
    f32x4 vb[3][4];
#pragma unroll
    for (int pre = 0; pre < 2; ++pre) if (pre < nrow) { const f32x4* xr = (const f32x4*)(xo + (size_t)(row0 + pre * stride) * 1024) + lane;
#pragma unroll
        for (int j = 0; j < 4; ++j) vb[pre][j] = xr[64 * j]; }
    for (int it0 = 0; it0 < nrow; it0 += 3) {
#pragma unroll
        for (int k = 0; k < 3; ++k) { const int it = it0 + k;
            if (it < nrow) {
                if (it + 2 < nrow) { const f32x4* xn = (const f32x4*)(xo + (size_t)(row0 + (it + 2) * stride) * 1024) + lane;
#pragma unroll
                    for (int j = 0; j < 4; ++j) vb[(k + 2) % 3][j] = xn[64 * j]; }
                f32x4* xr = (f32x4*)(xo + (size_t)(row0 + it * stride) * 1024) + lane;
                f32x4 v[4]; float ss = 0.f;
#pragma unroll
                for (int j = 0; j < 4; ++j) { v[j] = vb[k][j]; ss += (v[j][0] * v[j][0] + v[j][1] * v[j][1]) + (v[j][2] * v[j][2] + v[j][3] * v[j][3]); }
                const float rstd = rsqrtf(wave_sum(ss) * (1.f / 1024.f) + EPS);
#pragma unroll
                for (int j = 0; j < 4; ++j) xr[64 * j] = v[j] * rstd * nw[j];
            } }
    }
}

#ifndef EN_P0
#define EN_P0 1
#endif
#ifndef EN_P1
#define EN_P1 1
#endif
#ifndef EN_G1
#define EN_G1 1
#endif
#ifndef EN_B
#define EN_B 1
#endif
#ifndef EN_S1
#define EN_S1 1
#endif
#ifndef EN_A
#define EN_A 1
#endif
#ifndef EN_D
#define EN_D 1
#endif
#ifndef EN_SCAN
#define EN_SCAN 1
#endif
#ifndef EN_S2
#define EN_S2 1
#endif
#ifndef EN_G2
#define EN_G2 1
#endif
#ifndef EN_FIN
#define EN_FIN 1
#endif
#define XB_TMO      128
#define XB_XCNT(j)  (256  + 64 * (j))
#define XB_XSUB(j)  (1280 + 64 * (j))
#define XB_XGEN(j)  (2304 + 64 * (j))
#define XB_TOP      3328
#define XB_TOPGEN   3392
#define XCD_BAR_WORDS 3456
#define XB_SPIN_CAP (1u << 18)

__device__ __forceinline__ unsigned xb_ld(unsigned* p)              { return __hip_atomic_load(p, __ATOMIC_RELAXED, __HIP_MEMORY_SCOPE_AGENT); }
__device__ __forceinline__ unsigned xb_add(unsigned* p, unsigned v) { return __hip_atomic_fetch_add(p, v, __ATOMIC_RELAXED, __HIP_MEMORY_SCOPE_AGENT); }
__device__ __forceinline__ unsigned xb_xcc_id() { return (unsigned)__builtin_amdgcn_s_getreg((3 << 11) | 20) & 0xFu; }
#define XB_SPIN(cond, bar) do { unsigned _sp = 0; while (cond) { __builtin_amdgcn_s_sleep(1); \
    if ((++_sp & 255u) == 0u) { if (xb_ld(&(bar)[XB_TMO])) break; if (_sp > XB_SPIN_CAP) { atomicAdd(&(bar)[XB_TMO], 1u); break; } } } } while (0)

struct XcdBarrier {
    unsigned* bar; unsigned x;
    volatile LAS unsigned* st;
};

__device__ __forceinline__ XcdBarrier xcd_barrier_post(unsigned* bar, volatile LAS unsigned* st) {
    XcdBarrier b; b.bar = bar; b.x = xb_xcc_id(); b.st = st;
    if (threadIdx.x == 0) (void)xb_add(&bar[XB_XCNT(b.x)], 1u);
    return b;
}
__device__ __forceinline__ void xcd_barrier_complete(unsigned* bar, unsigned x, unsigned& nloc, unsigned& nx) {
    const unsigned G = gridDim.x * gridDim.y * gridDim.z;
    unsigned sum, cnt, mine, sp = 0u;
    for (;;) {
        sum = 0u; cnt = 0u; mine = 0u;
#pragma unroll
        for (unsigned j = 0; j < 16; ++j) { const unsigned c = xb_ld(&bar[XB_XCNT(j)]); sum += c; cnt += (c > 0u) ? 1u : 0u; mine = (j == x) ? c : mine; }
        if (sum == G) break;
        __builtin_amdgcn_s_sleep(1);
        if ((++sp & 255u) == 0u) { if (xb_ld(&bar[XB_TMO])) break; if (sp > XB_SPIN_CAP) { atomicAdd(&bar[XB_TMO], 1u); break; } }
    }
    nloc = mine > 0u ? mine : 1u; nx = cnt > 0u ? cnt : 1u;
}

__device__ __forceinline__ void xcd_barrier(const XcdBarrier& b) {
    asm volatile("s_waitcnt vmcnt(0)" ::: "memory");
    __syncthreads();
    if (threadIdx.x == 0) {
        unsigned* bar = b.bar;
        __builtin_amdgcn_s_waitcnt(0);
        unsigned nloc = b.st[0], nx = b.st[1];
        if (nloc == 0u) { xcd_barrier_complete(bar, b.x, nloc, nx); b.st[0] = nloc; b.st[1] = nx; }
        const unsigned old = xb_add(&bar[XB_XSUB(b.x)], 1u);
        const unsigned gen = old / nloc;
        if (old + 1u == (gen + 1u) * nloc) {
            __builtin_amdgcn_fence(__ATOMIC_RELEASE, "agent");
            asm volatile("s_waitcnt vmcnt(0)" ::: "memory");
            const unsigned og = xb_add(&bar[XB_TOP], 1u);
            const unsigned tg = og / nx;
            if (og + 1u == (tg + 1u) * nx) xb_add(&bar[XB_TOPGEN], 1u);
            else XB_SPIN(xb_ld(&bar[XB_TOPGEN]) == tg, bar);
            __builtin_amdgcn_fence(__ATOMIC_ACQUIRE, "agent");
            xb_add(&bar[XB_XGEN(b.x)], 1u);
            asm volatile("s_waitcnt vmcnt(0)" ::: "memory");
        } else {
            XB_SPIN(xb_ld(&bar[XB_XGEN(b.x)]) == gen, bar);
            __builtin_amdgcn_fence(__ATOMIC_ACQUIRE, "agent");
            asm volatile("s_waitcnt vmcnt(0)" ::: "memory");
        }
    }
    __syncthreads();
}

DI int hw_lane() { int l_; asm volatile("v_mbcnt_lo_u32_b32 %0, -1, 0\n\tv_mbcnt_hi_u32_b32 %0, -1, %0" : "=v"(l_)); return l_; }
struct Args { const float* in[17]; float* out; unsigned char* ws; int ph_lo, ph_hi; };
__global__ void __launch_bounds__(512) fwd_kernel(Args a) {
    extern __shared__ __attribute__((aligned(16))) unsigned char lds_raw[];
    cg::grid_group grid = cg::this_grid();
    LAS unsigned char* lds = (LAS unsigned char*)lds_raw;
    const int wave0 = __builtin_amdgcn_readfirstlane(threadIdx.x >> 6), G = gridDim.x;
#define TID0() (wave0 * 64 + hw_lane())
    const int lo = a.ph_lo, hi = a.ph_hi;
    if (hi > 1000) grid.sync();
    volatile LAS unsigned* bst = (volatile LAS unsigned*)(lds + 131072);
    if (TID0() < 16) bst[TID0()] = 0u;
    __syncthreads();
    XcdBarrier bar = xcd_barrier_post((unsigned*)(a.ws + WS_BAR), bst);
    unsigned char* ws = a.ws;
    bf16* WIN = (bf16*)(ws + WS_WIN); bf16* WOUT = (bf16*)(ws + WS_WOUT); float* MODP = (float*)(ws + WS_MODP); float* DT = (float*)(ws + WS_DT);
    float* TOT = (float*)(ws + WS_TOT); float* KMAX = (float*)(ws + WS_KMAX); bf16* WDT = (bf16*)(ws + WS_WDT); float* MODF = (float*)(ws + WS_MODF); float* LPA = (float*)(ws + WS_LPA); bf16* H = (bf16*)(ws + WS_H); bf16* YC = (bf16*)(ws + WS_YC); bf16* PROJ = (bf16*)(ws + WS_PROJ); float* STATES = (float*)(ws + WS_ST);
#define IN(k) (lo <= (k) && (k) < hi)
#define LAUNDER() int tp = TID0(); const int tid = tp, lane = tp & 63, wave = __builtin_amdgcn_readfirstlane(tp >> 6); (void)tid; (void)lane; (void)wave
#define SEAM(k) do { if (lo <= (k) && (k) + 1 < hi) { XcdBarrier b2_ = bar; asm volatile("" : "+s"(b2_.bar)); xcd_barrier(b2_); } } while (0)
    if (IN(0) && EN_P0) { LAUNDER(); phase0(a.in[1], a.in[3], a.in[5], a.in[15], WIN, WOUT, MODP, KMAX, WDT, lds, tid, G); }
    SEAM(0);
    for (int l = 0; l < 2; ++l) {
        const int pb = 1 + 6 * l;
        const float* modp = MODP + (size_t)l * 8 * 8 * 3072; const float* adab = a.in[4] + l * 3072;
        const float* xin = l == 0 ? a.in[0] : a.out;
        const bool fusedp = (G == 256);
        if (!(l == 1 && fusedp)) { if (IN(pb) && EN_P1) { LAUNDER(); phase_modulate(xin, a.in[2] + l * 1024, modp, adab, H, lds, tid, G, l == 0 ? MODF : nullptr, MODP, a.in[4]); }
            SEAM(pb); }
        if (IN(pb + 1) && EN_G1) { LAUNDER();
            pg8::Gemm g{H, WIN + (size_t)l * NP * 1024, M, NP, 1024}; pg8::StaticOrder S; S.init(M, NP, G, (int)blockIdx.x);
            pg8::EpiProj E{PROJ, (unsigned*)(KMAX + l * 1024), lds + 131072 + 1024};
            pg8::gemm_phase<pg8::EpiProj, pg8::StaticOrder, true, true>(lds, g, S, E, tp);
        }
        SEAM(pb + 1);
        if (IN(pb + 2)) {
            if (EN_B) { LAUNDER(); LAS char* vt = (LAS char*)lds + wave * 16384;
                (void)vt; for (int u = blockIdx.x; u < 256; u += G) { mixerB2_unit(u, l, PROJ, YC, a.in[6] + l * 128, a.in[7] + l * 64, KMAX + l * 1024, (LAS char*)lds, tid, wave, lane); } __syncthreads(); }
            if (EN_S1) { LAUNDER(); __syncthreads();
                for (int u = blockIdx.x; u < 256; u += G) ssd_part1_unit(u, PROJ, DT, H, WDT + l * 16384, a.in[11] + l * 8, a.in[8] + l * 5 * 768, a.in[9] + l * 768, a.in[10] + l * 8, STATES, TOT, lds, tid, wave, lane);
                __syncthreads(); }
            if (EN_A) { LAUNDER(); LAS char* vt = (LAS char*)lds + wave * 16384;
                for (int u = blockIdx.x; u < 512; u += G) { mixerA1_unit(u, PROJ, YC, LPA, KMAX + l * 1024, vt, wave, lane); } }
            if (EN_D) { LAUNDER(); LAS char* vt = (LAS char*)lds + wave * 16384;
                int hcur = -1; float rmax = 0.f;
                for (int u = blockIdx.x; u < 512; u += G) { const int hd = (u >> 4) & 3; if (hd != hcur) { rmax = d_stage_rpb(a.in[14] + l * 4 * 15 * 31, hd, vt, lane); hcur = hd; }
                    mixerD2_unit(u, PROJ, YC, rmax, KMAX + l * 1024, vt, wave, lane); } }
        }
        SEAM(pb + 2);
        if (IN(pb + 3) && EN_SCAN) { LAUNDER(); ssd_scan(STATES, TOT, blockIdx.x * 512 + tid, G * 512); }
        if (IN(pb + 3) && EN_A) { LAUNDER(); LAS char* vt = (LAS char*)lds + wave * 16384;
            for (int u = blockIdx.x; u < 512; u += G) { mixerA2_unit(u, PROJ, YC, LPA, KMAX + l * 1024, vt, wave, lane); } }
        SEAM(pb + 3);
        if (IN(pb + 4) && EN_S2) { LAUNDER();
            for (int u = blockIdx.x; u < 256; u += G)
                ssd_part2_unit(u, PROJ, DT, a.in[8] + l * 5 * 768, a.in[9] + l * 768, a.in[10] + l * 8, a.in[12] + l * 4, a.in[13] + l * 256, STATES, YC, lds, tid, wave, lane);
            __syncthreads();
        }
        SEAM(pb + 4);
        if (IN(pb + 5) && EN_G2) { LAUNDER();
            pg8::Gemm g{YC, WOUT + (size_t)l * 1024 * 1024, M, 1024, 1024}; pg8::StaticOrder S; S.init(M, 1024, G, (int)blockIdx.x);
            if (l == 1 && fusedp) {
                pg8::EpiOutFin E{xin, a.out, MODF + (size_t)l * 24576, a.in[16], (float*)(ws + WS_XCH2), (unsigned*)(ws + WS_BAR + 16384) + 32};
                pg8::gemm_phase<pg8::EpiOutFin, pg8::StaticOrder, true, true>(lds, g, S, E, tp);
            } else if (fusedp) {
                pg8::EpiOutMod E{xin, a.out, MODF, a.in[2] + 1024, MODF + 24576, H, (float*)(ws + WS_XCH), (unsigned*)(ws + WS_BAR + 16384)};
                pg8::gemm_phase<pg8::EpiOutMod, pg8::StaticOrder, true, true>(lds, g, S, E, tp);
            } else {
                pg8::EpiOut E{xin, a.out, MODF + (size_t)l * 24576};
                pg8::gemm_phase<pg8::EpiOut, pg8::StaticOrder, true, true>(lds, g, S, E, tp);
            }
        }
        if (!(l == 1 && fusedp)) SEAM(pb + 5);
    }
    if (IN(13) && EN_FIN && G != 256) { LAUNDER(); phase_final(a.out, a.in[16], tid, G); }
#undef IN
#undef SEAM
}

extern "C" void kernel_launch(void* const* d_in, const int* in_sizes, int n_in, void* d_out, int out_size, void* d_ws, size_t ws_size, hipStream_t stream) {
    static int grid = 0;
    if (grid == 0) {
        int dev = 0, cus = 0, per_cu = 0;
        hipGetDevice(&dev);
        hipDeviceGetAttribute(&cus, hipDeviceAttributeMultiprocessorCount, dev);
        hipFuncSetAttribute((const void*)fwd_kernel, hipFuncAttributeMaxDynamicSharedMemorySize, LDS_BYTES);
        hipOccupancyMaxActiveBlocksPerMultiprocessor(&per_cu, (const void*)fwd_kernel, 512, LDS_BYTES);
        if (per_cu < 1) per_cu = 1;
        grid = cus * per_cu;
        if (ws_size < WS_END) fprintf(stderr, "kernel_launch: workspace too small: %zu < %zu\n", ws_size, (size_t)WS_END);
        (void)hipGetLastError();
    }
    Args a{};
    for (int i = 0; i < 17; ++i) a.in[i] = (const float*)d_in[i];
    a.out = (float*)d_out; a.ws = (unsigned char*)d_ws; a.ph_lo = 0; a.ph_hi = 14;
    void* args[] = {&a};
    (void)hipMemsetAsync((char*)d_ws + WS_BAR, 0, 32768, stream);
    hipError_t e = hipLaunchCooperativeKernel((const void*)fwd_kernel, dim3(grid), dim3(512), args, LDS_BYTES, stream);
    if (e != hipSuccess) fprintf(stderr, "cooperative launch failed: %s (grid %d)\n", hipGetErrorString(e), grid);
}
```

```cpp
#include <hip/hip_runtime.h>
#include <hip/hip_cooperative_groups.h>
#include <cstdio>
#include <cstdint>
namespace cg = cooperative_groups;
namespace pg8 {
#define PG8_LAS __attribute__((address_space(3)))
typedef unsigned short bf16_t;
typedef short bf16x8 __attribute__((ext_vector_type(8)));
typedef float f32x4 __attribute__((ext_vector_type(4)));
typedef unsigned u32x4 __attribute__((ext_vector_type(4)));
constexpr int BM = 256, BK = 64, HALF = 128, HTB = HALF * BK * 2  , STAGE_BYTES = 8 * HTB, NXCD = 8, WGM = 8;

__host__ __device__ __forceinline__ int lds_byte(int r, int c) { const int st = (r >> 4) * 2 + (c >> 5), rr = r & 15, cc = c & 31, ob = rr * 64 + cc * 2; return st * 1024 + (ob ^ (((ob >> 9) & 1) << 5)); }
__host__ __device__ __forceinline__ void stage_rc(int b, int& R, int& C) { const int st = b / 1024, sb = b % 1024, swz = sb ^ (((sb >> 9) & 1) << 5); R = (st >> 1) * 16 + swz / 64; C = (st & 1) * 32 + (swz % 64) / 2; }
__host__ __device__ __forceinline__ int perm32(int rho) { const int n = rho >> 4, i = rho & 15; return 8 * (i >> 2) + 4 * n + (i & 3); }

struct Unit { int pm, pn; };
struct Gemm { const bf16_t* A; const bf16_t* Bt; int M, N, K; };

struct StaticOrder {
    int nM, nN, nwg, G, c;
    __host__ __device__ void init(int M, int N, int G_, int c_) { nM = M / BM; nN = N / BM; nwg = nM * nN; G = G_; c = c_; }
    __host__ __device__ bool next(int i, Unit& u) const {
        const long L = (long)i * G + c; if (L >= nwg) return false;
        int wgid = (int)L; { const int q = nwg / NXCD, r = nwg % NXCD, xcd = wgid % NXCD, off = wgid / NXCD; wgid = (xcd < r ? xcd * (q + 1) : r * (q + 1) + (xcd - r) * q) + off; }
        const int nig = WGM * nN, gid = wgid / nig, fm = gid * WGM, gsz = (nM - fm) < WGM ? (nM - fm) : WGM;
        u.pm = fm + ((wgid % nig) % gsz); u.pn = (wgid % nig) / gsz; return true;
    }
    __device__ __forceinline__ void a_ready(const Unit&) const {}
    __device__ __forceinline__ void done(const Unit&) const {}
};
__device__ __forceinline__ unsigned cvt_pk_bf16(float lo, float hi) { unsigned r; asm volatile("v_cvt_pk_bf16_f32 %0, %1, %2" : "=v"(r) : "v"(lo), "v"(hi)); return r; }
typedef unsigned u32x4e __attribute__((ext_vector_type(4)));
struct EpiProj {
    static constexpr bool PERM = true, AFTER_DRAIN = false;
    bf16_t* O; unsigned* kmax; PG8_LAS unsigned char* epl;
    __device__ __forceinline__ void operator()(const f32x4 (&acc)[2][2][4][2], const Unit& u, int wr, int wc, int fr, int fq) const {
        const int row0 = u.pm * BM + wr * 64 + fr; const int col0 = u.pn * BM + wc * 32 + 8 * fq;
#pragma unroll
        for (int ai = 0; ai < 2; ++ai)
#pragma unroll
            for (int m = 0; m < 4; ++m) {
#pragma unroll
                for (int bj = 0; bj < 2; ++bj) { const f32x4 v0 = acc[ai][bj][m][0], v1 = acc[ai][bj][m][1];
                    u32x4 w; w.x = cvt_pk_bf16(v0[0], v0[1]); w.y = cvt_pk_bf16(v0[2], v0[3]); w.z = cvt_pk_bf16(v1[0], v1[1]); w.w = cvt_pk_bf16(v1[2], v1[3]);
                    PG8_LAS unsigned char* tl = epl + (wr * 4 + wc) * 2048 + ((ai * 4 + m) * 2 + bj) % 2 * 1024;
                    const int ln = fq * 16 + fr;
                    *(PG8_LAS u32x4*)(tl + fr * 64 + ((fq ^ (fr >> 2)) & 3) * 16) = w;
                    const int r2 = ln >> 2, p2 = ln & 3;
                    const u32x4 w2 = *(const PG8_LAS u32x4*)(tl + r2 * 64 + ((p2 ^ (r2 >> 2)) & 3) * 16);
                    const int cc = u.pn * BM + bj * HALF + wc * 32;
                    bf16_t* dst = O + ((size_t)(cc >> 6) * 16384 + (size_t)(u.pm * BM + wr * 64 + ai * HALF + m * 16 + r2)) * 64 + (cc & 63) + p2 * 8;
                    *(u32x4*)dst = w2; } }
        if (u.pn == 1 || u.pn == 5 || u.pn == 13) {
            float mx[2] = {0.f, 0.f};
#pragma unroll
            for (int ai = 0; ai < 2; ++ai)
#pragma unroll
                for (int m = 0; m < 4; ++m)
#pragma unroll
                    for (int bj = 0; bj < 2; ++bj) { const f32x4 v0 = acc[ai][bj][m][0], v1 = acc[ai][bj][m][1];
                        float ss = (v0[0] * v0[0] + v0[1] * v0[1]) + (v0[2] * v0[2] + v0[3] * v0[3]) + (v1[0] * v1[0] + v1[1] * v1[1]) + (v1[2] * v1[2] + v1[3] * v1[3]);
                        ss += __shfl_xor(ss, 16); ss += __shfl_xor(ss, 32); mx[bj] = fmaxf(mx[bj], ss); }
#pragma unroll
            for (int bj = 0; bj < 2; ++bj) {
#pragma unroll
                for (int o = 1; o < 16; o <<= 1) mx[bj] = fmaxf(mx[bj], __shfl_xor(mx[bj], o));
                if (fr == 0 && fq == 0) __hip_atomic_fetch_max(kmax + ((u.pm * BM) >> 11) * 128 + u.pn * 8 + bj * 4 + wc, __builtin_bit_cast(unsigned, mx[bj]), __ATOMIC_RELAXED, __HIP_MEMORY_SCOPE_AGENT); }
        }
    }
};
struct EpiOut {
    static constexpr bool PERM = false, AFTER_DRAIN = false;
    const float* xin; float* xout; const float* modf;
    __device__ __forceinline__ void operator()(const f32x4 (&acc)[2][2][4][2], const Unit& u, int wr, int wc, int fr, int fq) const {
        const int row0 = u.pm * BM + wr * 64 + fr; const int col0 = u.pn * BM + wc * 32 + 4 * fq;
        const int b = (u.pm * BM) >> 11;
        f32x4 gt[2][2];
#pragma unroll
        for (int bj = 0; bj < 2; ++bj)
#pragma unroll
            for (int n = 0; n < 2; ++n) gt[bj][n] = *(const f32x4*)(modf + (size_t)b * 3072 + 2048 + col0 + bj * HALF + 16 * n);
#pragma unroll
        for (int ai = 0; ai < 2; ++ai)
#pragma unroll
            for (int m = 0; m < 4; ++m) { const size_t ro = (size_t)(row0 + ai * HALF + m * 16) * 1024 + col0;
#pragma unroll
                for (int bj = 0; bj < 2; ++bj)
#pragma unroll
                    for (int n = 0; n < 2; ++n) { const size_t o = ro + bj * HALF + 16 * n; const f32x4 xi = *(const f32x4*)(xin + o);
                        *(f32x4*)(xout + o) = xi + gt[bj][n] * acc[ai][bj][m][n]; } }
    }
};
struct EpiOutFin {
    static constexpr bool PERM = false, AFTER_DRAIN = true;
    const float* xin; float* xout; const float* modf; const float* fw; float* xch; unsigned* cnt;
    __device__ __forceinline__ void operator()(const f32x4 (&acc)[2][2][4][2], const Unit& u, int wr, int wc, int fr, int fq) const {}
    __device__ __forceinline__ void fused(f32x4 (&acc)[2][2][4][2], const Unit& u, int wr, int wc, int fr, int fq, PG8_LAS unsigned char* lds, int wid, int lane) const {
        const int row0 = u.pm * BM + wr * 64 + fr; const int col0 = u.pn * BM + wc * 32 + 4 * fq;
        const int b = (u.pm * BM) >> 11;
        PG8_LAS float* P = (PG8_LAS float*)lds; PG8_LAS float* S = P + 1024;
        f32x4 gt[2][2];
#pragma unroll
        for (int bj = 0; bj < 2; ++bj)
#pragma unroll
            for (int n = 0; n < 2; ++n) gt[bj][n] = *(const f32x4*)(modf + (size_t)b * 3072 + 2048 + col0 + bj * HALF + 16 * n);
#pragma unroll
        for (int ai = 0; ai < 2; ++ai)
#pragma unroll
            for (int m = 0; m < 4; ++m) { const size_t ro = (size_t)(row0 + ai * HALF + m * 16) * 1024 + col0; float s = 0.f;
#pragma unroll
                for (int bj = 0; bj < 2; ++bj)
#pragma unroll
                    for (int n = 0; n < 2; ++n) { const f32x4 xi = __builtin_nontemporal_load((const f32x4*)(xin + ro + bj * HALF + 16 * n));
                        const f32x4 v = xi + gt[bj][n] * acc[ai][bj][m][n]; acc[ai][bj][m][n] = v;
                        s += (v[0] * v[0] + v[1] * v[1]) + (v[2] * v[2] + v[3] * v[3]); }
                s += __shfl_xor(s, 16); s += __shfl_xor(s, 32);
                if (fq == 0) P[(ai * HALF + wr * 64 + m * 16 + fr) * 4 + wc] = s; }
        __syncthreads();
        const int t = wid * 64 + lane;
        if (t < 256) { const float rs = (P[t * 4] + P[t * 4 + 1]) + (P[t * 4 + 2] + P[t * 4 + 3]);
            __hip_atomic_store(xch + ((size_t)u.pm * 256 + t) * 4 + u.pn, rs, __ATOMIC_RELAXED, __HIP_MEMORY_SCOPE_AGENT); }
        asm volatile("s_waitcnt vmcnt(0)" ::: "memory");
        __syncthreads();
        if (t == 0) {
            __hip_atomic_fetch_add(cnt + 64 * u.pm, 1u, __ATOMIC_RELAXED, __HIP_MEMORY_SCOPE_AGENT);
            unsigned sp = 0;
            while (__hip_atomic_load(cnt + 64 * u.pm, __ATOMIC_RELAXED, __HIP_MEMORY_SCOPE_AGENT) < 4u) { __builtin_amdgcn_s_sleep(1); if (++sp > (1u << 22)) break; }
        }
        __syncthreads();
        if (t < 256) { float tot = 0.f;
#pragma unroll
            for (int pn2 = 0; pn2 < 4; ++pn2) tot += __hip_atomic_load(xch + ((size_t)u.pm * 256 + t) * 4 + pn2, __ATOMIC_RELAXED, __HIP_MEMORY_SCOPE_AGENT);
            S[t] = rsqrtf(tot * (1.f / 1024.f) + 1e-6f); }
        __syncthreads();
        f32x4 fwv[2][2];
#pragma unroll
        for (int bj = 0; bj < 2; ++bj)
#pragma unroll
            for (int n = 0; n < 2; ++n) fwv[bj][n] = *(const f32x4*)(fw + col0 + bj * HALF + 16 * n);
#pragma unroll
        for (int ai = 0; ai < 2; ++ai)
#pragma unroll
            for (int m = 0; m < 4; ++m) { const float rstd = S[ai * HALF + wr * 64 + m * 16 + fr]; const size_t ro = (size_t)(row0 + ai * HALF + m * 16) * 1024 + col0;
#pragma unroll
                for (int bj = 0; bj < 2; ++bj)
#pragma unroll
                    for (int n = 0; n < 2; ++n) *(f32x4*)(xout + ro + bj * HALF + 16 * n) = acc[ai][bj][m][n] * rstd * fwv[bj][n]; }
        __syncthreads();
    }
};
struct EpiOutMod {
    static constexpr bool PERM = false, AFTER_DRAIN = true;
    const float* xin; float* xout; const float* modf; const float* nw; const float* modf2; bf16_t* Hn; float* xch; unsigned* cnt;
    __device__ __forceinline__ void operator()(const f32x4 (&acc)[2][2][4][2], const Unit& u, int wr, int wc, int fr, int fq) const {}
    __device__ __forceinline__ void fused(f32x4 (&acc)[2][2][4][2], const Unit& u, int wr, int wc, int fr, int fq, PG8_LAS unsigned char* lds, int wid, int lane) const {
        const int row0 = u.pm * BM + wr * 64 + fr; const int col0 = u.pn * BM + wc * 32 + 4 * fq;
        const int b = (u.pm * BM) >> 11;
        PG8_LAS float* P = (PG8_LAS float*)lds; PG8_LAS float* S = P + 1024;
        {
        f32x4 gt[2][2];
#pragma unroll
        for (int bj = 0; bj < 2; ++bj)
#pragma unroll
            for (int n = 0; n < 2; ++n) gt[bj][n] = *(const f32x4*)(modf + (size_t)b * 3072 + 2048 + col0 + bj * HALF + 16 * n);
#pragma unroll
        for (int ai = 0; ai < 2; ++ai)
#pragma unroll
            for (int m = 0; m < 4; ++m) { const size_t ro = (size_t)(row0 + ai * HALF + m * 16) * 1024 + col0; float s = 0.f;
#pragma unroll
                for (int bj = 0; bj < 2; ++bj)
#pragma unroll
                    for (int n = 0; n < 2; ++n) { const f32x4 xi = __builtin_nontemporal_load((const f32x4*)(xin + ro + bj * HALF + 16 * n));
                        const f32x4 v = xi + gt[bj][n] * acc[ai][bj][m][n]; acc[ai][bj][m][n] = v;
                        *(f32x4*)(xout + ro + bj * HALF + 16 * n) = v;
                        s += (v[0] * v[0] + v[1] * v[1]) + (v[2] * v[2] + v[3] * v[3]); }
                s += __shfl_xor(s, 16); s += __shfl_xor(s, 32);
                if (fq == 0) P[(ai * HALF + wr * 64 + m * 16 + fr) * 4 + wc] = s; }
        }
        __syncthreads();
        const int t = wid * 64 + lane;
        if (t < 256) { const float rs = (P[t * 4] + P[t * 4 + 1]) + (P[t * 4 + 2] + P[t * 4 + 3]);
            __hip_atomic_store(xch + ((size_t)u.pm * 256 + t) * 4 + u.pn, rs, __ATOMIC_RELAXED, __HIP_MEMORY_SCOPE_AGENT); }
        asm volatile("s_waitcnt vmcnt(0)" ::: "memory");
        __syncthreads();
        if (t == 0) {
            __hip_atomic_fetch_add(cnt + 64 * u.pm, 1u, __ATOMIC_RELAXED, __HIP_MEMORY_SCOPE_AGENT);
            unsigned sp = 0;
            while (__hip_atomic_load(cnt + 64 * u.pm, __ATOMIC_RELAXED, __HIP_MEMORY_SCOPE_AGENT) < 4u) { __builtin_amdgcn_s_sleep(1); if (++sp > (1u << 22)) break; }
        }
        f32x4 mul[2][2], add[2][2];
#pragma unroll
        for (int bj = 0; bj < 2; ++bj)
#pragma unroll
            for (int n = 0; n < 2; ++n) { const int c = col0 + bj * HALF + 16 * n;
                mul[bj][n] = *(const f32x4*)(nw + c) * (*(const f32x4*)(modf2 + (size_t)b * 3072 + 1024 + c) + 1.f); add[bj][n] = *(const f32x4*)(modf2 + (size_t)b * 3072 + c); }
        __syncthreads();
        if (t < 256) { float tot = 0.f;
#pragma unroll
            for (int pn2 = 0; pn2 < 4; ++pn2) tot += __hip_atomic_load(xch + ((size_t)u.pm * 256 + t) * 4 + pn2, __ATOMIC_RELAXED, __HIP_MEMORY_SCOPE_AGENT);
            S[t] = rsqrtf(tot * (1.f / 1024.f) + 1e-6f); }
        __syncthreads();
#pragma unroll
        for (int ai = 0; ai < 2; ++ai)
#pragma unroll
            for (int m = 0; m < 4; ++m) { const float rstd = S[ai * HALF + wr * 64 + m * 16 + fr]; bf16_t* hp = Hn + (size_t)(row0 + ai * HALF + m * 16) * 1024 + col0;
#pragma unroll
                for (int bj = 0; bj < 2; ++bj) { const f32x4 h0 = acc[ai][bj][m][0] * rstd * mul[bj][0] + add[bj][0], h1 = acc[ai][bj][m][1] * rstd * mul[bj][1] + add[bj][1];
                    typedef unsigned u32x2e __attribute__((ext_vector_type(2)));
                    u32x2e w0, w1; w0.x = cvt_pk_bf16(h0[0], h0[1]); w0.y = cvt_pk_bf16(h0[2], h0[3]); w1.x = cvt_pk_bf16(h1[0], h1[1]); w1.y = cvt_pk_bf16(h1[2], h1[3]);
                    *(u32x2e*)(hp + bj * HALF) = w0; *(u32x2e*)(hp + bj * HALF + 16) = w1; } }
        __syncthreads();
    }
};
template <class Epi, class Sched, bool ALIGN_EPI = false, bool SP2 = false>
__device__ __forceinline__ void gemm_phase(PG8_LAS unsigned char* lds, const Gemm g, const Sched& S, const Epi& E, const int tid) {
    const int wid = __builtin_amdgcn_readfirstlane(tid >> 6), lane = tid & 63, wr = wid >> 2, wc = wid & 3, fr = lane & 15, fq = lane >> 4;
    const int K = g.K, nt = K / BK;
    unsigned voffA[2], voffB[2];
#pragma unroll
    for (int i = 0; i < 2; ++i) { int R, C; stage_rc(tid * 16 + i * 8192, R, C); const int Rb = Epi::PERM ? ((R & ~31) + perm32(R & 31)) : R;
        voffA[i] = (unsigned)(R * K + C) * 2u; voffB[i] = (unsigned)(Rb * K + C) * 2u; }
    const size_t kstep = (size_t)(BK * 2);
    const size_t hstep = (size_t)HALF * K * 2;
    const size_t tstep = 2 * hstep;
    const unsigned ldsw = (unsigned)wid * 1024u;
    const int aoff = lds_byte(wr * 64 + fr, fq * 8), boff = lds_byte(wc * 32 + fr, fq * 8);
#define PG8_SA(b, h) (((b) * 2 + (h)) * HTB)
#define PG8_SB(b, h) ((4 + (b) * 2 + (h)) * HTB)
#define PG8_STAGE(bufoff, gbase, voff) do { _Pragma("unroll") for (int _i = 0; _i < 2; ++_i) \
        __builtin_amdgcn_global_load_lds((const unsigned*)((const char*)(gbase) + (voff)[_i]), (PG8_LAS unsigned*)(lds + (bufoff) + ldsw + _i * 8192), 16, 0, 0); } while (0)
#define PG8_LDA(dst, b, h) do { _Pragma("unroll") for (int m = 0; m < 4; ++m) _Pragma("unroll") for (int k = 0; k < 2; ++k) dst[m][k] = *(const PG8_LAS bf16x8*)(lds + PG8_SA(b, h) + aoff + m * 2048 + k * 1024); } while (0)
#define PG8_LDB(dst, b, h) do { _Pragma("unroll") for (int n = 0; n < 2; ++n) _Pragma("unroll") for (int k = 0; k < 2; ++k) dst[n][k] = *(const PG8_LAS bf16x8*)(lds + PG8_SB(b, h) + boff + n * 2048 + k * 1024); } while (0)
#define PG8_MMA(ai, bj, At, Bt) do { __builtin_amdgcn_s_setprio(1); _Pragma("unroll") for (int m = 0; m < 4; ++m) _Pragma("unroll") for (int n = 0; n < 2; ++n) _Pragma("unroll") for (int k = 0; k < 2; ++k) \
        acc[ai][bj][m][n] = __builtin_amdgcn_mfma_f32_16x16x32_bf16(Bt[n][k], At[m][k], acc[ai][bj][m][n], 0, 0, 0); __builtin_amdgcn_s_setprio(0); } while (0)
#define PG8_WAIT_V(n) asm volatile("s_waitcnt vmcnt(" #n ")" ::: "memory")
#define PG8_WAIT_L(n) asm volatile("s_waitcnt lgkmcnt(" #n ")" ::: "memory")
#define PG8_BAR __builtin_amdgcn_s_barrier()
#define PG8_SCHED __builtin_amdgcn_sched_barrier(0)
    Unit cur, nxt; int ui = 0;
    if (!S.next(0, cur)) return;
    f32x4 acc[2][2][4][2];
#pragma unroll
    for (int a = 0; a < 2; ++a)
#pragma unroll
        for (int b = 0; b < 2; ++b)
#pragma unroll
            for (int m = 0; m < 4; ++m)
#pragma unroll
                for (int n = 0; n < 2; ++n) acc[a][b][m][n] = (f32x4){0.f, 0.f, 0.f, 0.f};
    bf16x8 At[4][2], B0[2][2], B1[2][2];
    const char* cA = (const char*)g.A + (size_t)cur.pm * tstep; const char* cB = (const char*)g.Bt + (size_t)cur.pn * tstep;
    S.a_ready(cur);
    if constexpr (SP2) {
        PG8_STAGE(PG8_SB(0, 0), cB, voffB); PG8_STAGE(PG8_SB(0, 1), cB + hstep, voffB); PG8_STAGE(PG8_SA(0, 0), cA, voffA); PG8_STAGE(PG8_SA(0, 1), cA + hstep, voffA);
        if (wr == 1) PG8_BAR;
        PG8_WAIT_V(2); PG8_BAR;
        PG8_STAGE(PG8_SB(1, 0), cB + kstep, voffB); PG8_STAGE(PG8_SA(1, 0), cA + kstep, voffA); PG8_STAGE(PG8_SB(1, 1), cB + hstep + kstep, voffB);
        PG8_WAIT_V(6); PG8_BAR;
    } else {
        PG8_STAGE(PG8_SB(0, 0), cB, voffB); PG8_STAGE(PG8_SA(0, 0), cA, voffA); PG8_STAGE(PG8_SB(0, 1), cB + hstep, voffB); PG8_STAGE(PG8_SA(0, 1), cA + hstep, voffA);
        if (wr == 1) PG8_BAR;
        PG8_WAIT_V(4); PG8_BAR;
        PG8_STAGE(PG8_SB(1, 0), cB + kstep, voffB); PG8_STAGE(PG8_SA(1, 0), cA + kstep, voffA); PG8_STAGE(PG8_SB(1, 1), cB + hstep + kstep, voffB);
        PG8_WAIT_V(6); PG8_BAR;
    }
    for (;;) {
        const bool has_next = S.next(ui + 1, nxt);
        const char* nA = has_next ? (const char*)g.A + (size_t)nxt.pm * tstep : cA; const char* nB = has_next ? (const char*)g.Bt + (size_t)nxt.pn * tstep : cB;
        for (int t = 0; t < nt; t += 2) {
            const bool last = (t == nt - 2);
            const char* a1 = cA + (size_t)(t + 1) * kstep;
            const char* a2 = last ? nA : cA + (size_t)(t + 2) * kstep; const char* b2 = last ? nB : cB + (size_t)(t + 2) * kstep;
            const char* a3 = a2 + kstep; const char* b3 = b2 + kstep;
            if (last && has_next) S.a_ready(nxt);
            if constexpr (SP2) {
            PG8_LDB(B0, 0, 0); PG8_LDB(B1, 0, 1); PG8_SCHED; PG8_LDA(At, 0, 0); PG8_STAGE(PG8_SA(1, 1), a1 + hstep, voffA);
            PG8_WAIT_V(8); PG8_WAIT_L(0); PG8_BAR; PG8_MMA(0, 0, At, B0); PG8_MMA(0, 1, At, B1); PG8_BAR; PG8_SCHED;
            PG8_LDA(At, 0, 1); PG8_STAGE(PG8_SB(0, 0), b2, voffB); PG8_STAGE(PG8_SB(0, 1), b2 + hstep, voffB); PG8_STAGE(PG8_SA(0, 0), a2, voffA);
            PG8_WAIT_V(8); PG8_WAIT_L(0); PG8_BAR; PG8_MMA(1, 0, At, B0); PG8_MMA(1, 1, At, B1); PG8_BAR; PG8_SCHED;
            PG8_LDB(B0, 1, 0); PG8_LDB(B1, 1, 1); PG8_SCHED; PG8_LDA(At, 1, 0); PG8_STAGE(PG8_SA(0, 1), a2 + hstep, voffA);
            PG8_WAIT_V(8); PG8_WAIT_L(0); PG8_BAR; PG8_MMA(0, 0, At, B0); PG8_MMA(0, 1, At, B1); PG8_BAR; PG8_SCHED;
            PG8_LDA(At, 1, 1); PG8_STAGE(PG8_SB(1, 0), b3, voffB); PG8_STAGE(PG8_SB(1, 1), b3 + hstep, voffB); PG8_STAGE(PG8_SA(1, 0), a3, voffA);
            PG8_WAIT_V(8); PG8_WAIT_L(0); PG8_BAR; PG8_MMA(1, 0, At, B0); PG8_MMA(1, 1, At, B1); PG8_BAR; PG8_SCHED;
            } else {
            PG8_LDB(B0, 0, 0); PG8_SCHED; PG8_LDA(At, 0, 0); PG8_STAGE(PG8_SA(1, 1), a1 + hstep, voffA);
            PG8_WAIT_L(8); PG8_BAR; PG8_WAIT_L(0); PG8_MMA(0, 0, At, B0); PG8_BAR; PG8_SCHED;
            PG8_LDB(B1, 0, 1); PG8_STAGE(PG8_SB(0, 0), b2, voffB);
            PG8_BAR; PG8_WAIT_L(0); PG8_MMA(0, 1, At, B1); PG8_BAR;
            PG8_LDA(At, 0, 1); PG8_STAGE(PG8_SA(0, 0), a2, voffA);
            PG8_BAR; PG8_WAIT_L(0); PG8_MMA(1, 0, At, B0); PG8_BAR; PG8_SCHED;
            PG8_STAGE(PG8_SB(0, 1), b2 + hstep, voffB);
            PG8_WAIT_V(6); PG8_BAR; PG8_MMA(1, 1, At, B1); PG8_BAR;
            PG8_LDB(B0, 1, 0); PG8_SCHED; PG8_LDA(At, 1, 0); PG8_STAGE(PG8_SA(0, 1), a2 + hstep, voffA);
            PG8_WAIT_L(8); PG8_BAR; PG8_WAIT_L(0); PG8_MMA(0, 0, At, B0); PG8_BAR; PG8_SCHED;
            PG8_LDB(B1, 1, 1); PG8_STAGE(PG8_SB(1, 0), b3, voffB);
            PG8_BAR; PG8_WAIT_L(0); PG8_MMA(0, 1, At, B1); PG8_BAR;
            PG8_LDA(At, 1, 1); PG8_STAGE(PG8_SA(1, 0), a3, voffA);
            PG8_BAR; PG8_WAIT_L(0); PG8_MMA(1, 0, At, B0); PG8_BAR; PG8_SCHED;
            PG8_STAGE(PG8_SB(1, 1), b3 + hstep, voffB);
            PG8_WAIT_V(6); PG8_BAR; PG8_MMA(1, 1, At, B1); PG8_BAR;
            }
        }
        if constexpr (ALIGN_EPI) { if (wr == 0) PG8_BAR; }
        if constexpr (!Epi::AFTER_DRAIN) { E(acc, cur, wr, wc, fr, fq); S.done(cur); }
        if (!has_next) break;
#pragma unroll
        for (int a = 0; a < 2; ++a)
#pragma unroll
            for (int b = 0; b < 2; ++b)
#pragma unroll
                for (int m = 0; m < 4; ++m)
#pragma unroll
                    for (int n = 0; n < 2; ++n) acc[a][b][m][n] = (f32x4){0.f, 0.f, 0.f, 0.f};
        cur = nxt; cA = nA; cB = nB; ++ui;
        if constexpr (ALIGN_EPI) { if (wr == 1) PG8_BAR; }
    }
    PG8_WAIT_V(0);
    if constexpr (!ALIGN_EPI) { if (wr == 0) PG8_BAR; }
    PG8_BAR;
    if constexpr (Epi::AFTER_DRAIN) { E.fused(acc, cur, wr, wc, fr, fq, lds, wid, lane); S.done(cur); }
#undef PG8_SA
#undef PG8_SB
#undef PG8_STAGE
#undef PG8_LDA
#undef PG8_LDB
#undef PG8_MMA
#undef PG8_WAIT_V
#undef PG8_WAIT_L
#undef PG8_BAR
#undef PG8_SCHED
}
}
#define DI __device__ __forceinline__
#define LAS __attribute__((address_space(3)))
typedef unsigned short bf16;
typedef float f32x4 __attribute__((ext_vector_type(4)));
typedef float f32x2_t __attribute__((ext_vector_type(2)));
typedef __bf16 bf16x2_t __attribute__((ext_vector_type(2)));
typedef short bf16x8 __attribute__((ext_vector_type(8)));
typedef short s16x4 __attribute__((ext_vector_type(4)));
typedef unsigned u32x4 __attribute__((ext_vector_type(4)));
typedef unsigned u32x2 __attribute__((ext_vector_type(2)));
#define MFMA16(a, b, c) __builtin_amdgcn_mfma_f32_16x16x32_bf16((a), (b), (c), 0, 0, 0)

constexpr int NB = 8, T = 2048, D = 1024, M = NB * T, DIN = 4104, NP = 4096;
constexpr float EPS = 1e-6f, LOG2E = 1.4426950408889634f;
constexpr int C_AQ = 0, C_AK = 256, C_AV = 512, C_AG = 768, C_BQ = 1024, C_BK = 1280, C_BV = 1536, C_BG = 1792,
              C_CZ = 2048, C_CX = 2304, C_DQ = 3072, C_DK = 3328, C_DV = 3584, C_DG = 3840;
constexpr size_t MiB = (size_t)1 << 20;
constexpr size_t WS_WIN = 0, WS_WOUT = 16 * MiB, WS_MODP = 20 * MiB, WS_DT = 22 * MiB, WS_TOT = 23 * MiB, WS_KMAX = 23 * MiB + 256 * 1024, WS_WDT = 23 * MiB + 320 * 1024, WS_XCH = 23 * MiB + 640 * 1024, WS_MODF = 21 * MiB + 512 * 1024, WS_XCH2 = 22 * MiB + 512 * 1024, WS_LPA = 22 * MiB + 768 * 1024, WS_BAR = 23 * MiB + 512 * 1024, WS_H = 24 * MiB,
                 WS_PROJ = 56 * MiB, WS_ST = 184 * MiB, WS_YC = 216 * MiB, WS_END = 248 * MiB;
constexpr int LDS_BYTES = 131072 + 1024 + 16384;
constexpr int IMG_PITCH = 272, IMG_BYTES = 128 * IMG_PITCH;
constexpr int VT_PITCH = 144;

DI unsigned pk2(float lo, float hi) { f32x2_t v = {lo, hi}; bf16x2_t b = __builtin_convertvector(v, bf16x2_t); return __builtin_bit_cast(unsigned, b); }
DI float bflo(unsigned u) { return __builtin_bit_cast(float, u << 16); }
DI float bfhi(unsigned u) { return __builtin_bit_cast(float, u & 0xffff0000u); }
DI float wave_sum(float v) {
#pragma unroll
    for (int o = 1; o < 64; o <<= 1) v += __shfl_xor(v, o);
    return v;
}
DI float silu_f(float x) { return x * __builtin_amdgcn_rcpf(1.f + __expf(-x)); }
DI float ex2(float x) { return __builtin_amdgcn_exp2f(x); }
DI s16x4 vtr(const LAS char* p) { return __builtin_bit_cast(s16x4, __builtin_amdgcn_ds_read_tr16_b64_v4i16((LAS s16x4*)p)); }
DI bf16x8 cat8(s16x4 lo, s16x4 hi) { return __builtin_shufflevector(lo, hi, 0, 1, 2, 3, 4, 5, 6, 7); }
DI bf16x8 pack8(f32x4 a, f32x4 b) { u32x4 w; w.x = pk2(a[0], a[1]); w.y = pk2(a[2], a[3]); w.z = pk2(b[0], b[1]); w.w = pk2(b[2], b[3]); return __builtin_bit_cast(bf16x8, w); }
#define LDS_WAIT() asm volatile("s_waitcnt lgkmcnt(0)" ::: "memory")

DI void p0_transpose_item(const float* W, int ldw, int srccol, float scale, bf16* WT, int k0, LAS float* scr, int lane) {
    f32x4 wv[8];
#pragma unroll
    for (int i = 0; i < 8; ++i) wv[i] = __builtin_nontemporal_load((const f32x4*)(W + (size_t)(k0 + 8 * i + (lane >> 3)) * ldw + srccol + 4 * (lane & 7)));
#pragma unroll
    for (int i = 0; i < 8; ++i) { LAS float* d = scr + (8 * i + (lane >> 3)) * 33 + 4 * (lane & 7);
        d[0] = wv[i][0] * scale; d[1] = wv[i][1] * scale; d[2] = wv[i][2] * scale; d[3] = wv[i][3] * scale; }
    LDS_WAIT();
    const int c = lane & 7;
#pragma unroll
    for (int j = 0; j < 4; ++j) { const int n = (lane >> 3) + 8 * j; const LAS float* s = scr + (8 * c) * 33 + n;
        u32x4 o; o.x = pk2(s[0 * 33], s[1 * 33]); o.y = pk2(s[2 * 33], s[3 * 33]); o.z = pk2(s[4 * 33], s[5 * 33]); o.w = pk2(s[6 * 33], s[7 * 33]);
        *(u32x4*)(WT + (size_t)n * 1024 + k0 + 8 * c) = o; }
    LDS_WAIT();
}
DI void phase0(const float* cvec, const float* ada_w, const float* w_in, const float* w_out, bf16* WIN, bf16* WOUT, float* MODP, float* KMAX, bf16* WDT,
               LAS unsigned char* lds, int tid, int G) {
    const int lane = tid & 63, wave = tid >> 6;
    if (blockIdx.x == 0) for (int i = tid; i < 2 * 8 * 128; i += 512) KMAX[i] = 0.f;
    for (int i = blockIdx.x * 512 + tid; i < 32768; i += G * 512) { const int l = i >> 14, jj = (i >> 10) & 15, col = i & 1023;
        WDT[i] = jj < 8 ? (bf16)(pk2(w_in[((size_t)l * 1024 + col) * DIN + 3072 + jj], 0.f) & 0xffffu) : (bf16)0; }
    LAS float* scr = (LAS float*)(lds + wave * 16384);
    const int gw = blockIdx.x * 8 + wave, NGW = G * 8;
    constexpr int I_IN = 16 * 128, I_OUT = 16 * 32, I_L = I_IN + I_OUT;
    for (int it = gw; it < 2 * I_L; it += NGW) {
        const int l = it / I_L; int r = it - l * I_L;
        if (r < I_IN) {
            const int kb = r >> 7, nb = r & 127, n0 = 32 * nb; const int src = n0 + (n0 >= 3072 ? 8 : 0);
            float sc = 1.f;
            if (n0 < 256) sc = 0.125f * LOG2E; else if (n0 >= 1024 && n0 < 1280) sc = 0.17677669529663687f * LOG2E; else if (n0 >= 3072 && n0 < 3328) sc = 0.125f * LOG2E;
            p0_transpose_item(w_in + (size_t)l * 1024 * DIN, DIN, src, sc, WIN + ((size_t)l * NP + n0) * 1024, 64 * kb, scr, lane);
        } else {
            r -= I_IN; const int kb = r >> 5, nb = r & 31, n0 = 32 * nb;
            p0_transpose_item(w_out + (size_t)l * 1024 * 1024, 1024, n0, 1.f, WOUT + ((size_t)l * 1024 + n0) * 1024, 64 * kb, scr, lane);
        }
    }
    __syncthreads();
    for (int task = blockIdx.x; task < 192; task += G) {
        const int l = task / 96, rem = task % 96, cgp = rem >> 3, ks = rem & 7;
        const float* W = ada_w + (size_t)l * 1024 * 3072;
        const int k0 = ks * 128 + wave * 16, col = cgp * 256 + lane * 4;
        f32x4 acc[8];
#pragma unroll
        for (int b = 0; b < 8; ++b) acc[b] = (f32x4){0.f, 0.f, 0.f, 0.f};
#pragma unroll 4
        for (int kk = 0; kk < 16; ++kk) { const int k = k0 + kk; const f32x4 w = __builtin_nontemporal_load((const f32x4*)(W + (size_t)k * 3072 + col));
#pragma unroll
            for (int b = 0; b < 8; ++b) { const float ca = silu_f(cvec[b * 1024 + k]); acc[b] += w * ca; } }
        LAS float* red = (LAS float*)lds;
#pragma unroll
        for (int b = 0; b < 8; ++b) *(LAS f32x4*)(red + (wave * 8 + b) * 256 + lane * 4) = acc[b];
        __syncthreads();
        { const int idx = tid * 4, b = idx >> 8, cc = idx & 255; f32x4 s = (f32x4){0.f, 0.f, 0.f, 0.f};
#pragma unroll
          for (int w = 0; w < 8; ++w) s += *(const LAS f32x4*)(red + (w * 8 + b) * 256 + cc);
          *(f32x4*)(MODP + ((size_t)(l * 8 + ks) * 8 + b) * 3072 + cgp * 256 + cc) = s; }
        __syncthreads();
    }
}

DI void phase_modulate(const float* xin, const float* norm_w, const float* modp, const float* adab,
                       bf16* H, LAS unsigned char* lds, int tid, int G, float* MODF, const float* MODP_all, const float* adab_all) {
    const int lane = tid & 63, wave = tid >> 6;
    if (MODF) for (int idx = blockIdx.x * 512 + tid; idx < 2 * 8 * 3072; idx += G * 512) { const int l2 = idx / 24576, rem = idx - l2 * 24576, b2 = rem / 3072, c2 = rem - b2 * 3072;
        float v = adab_all[l2 * 3072 + c2];
#pragma unroll
        for (int ks = 0; ks < 8; ++ks) v += MODP_all[((size_t)(l2 * 8 + ks) * 8 + b2) * 3072 + c2];
        MODF[idx] = v; }
    LAS float* sh = (LAS float*)lds; LAS float* sc = sh + 1024;
    __syncthreads();
    f32x4 nw[4];
#pragma unroll
    for (int j = 0; j < 4; ++j) nw[j] = *(const f32x4*)(norm_w + 4 * lane + 256 * j);
    int curb = -1;
    for (int rb = blockIdx.x; rb < 256; rb += G) {
        const int b = rb >> 5;
        if (b != curb) {
            __syncthreads();
            for (int i = tid; i < 2048; i += 512) { float v = adab[i];
#pragma unroll
                for (int ks = 0; ks < 8; ++ks) v += modp[(size_t)(ks * 8 + b) * 3072 + i];
                sh[i] = (i >= 1024) ? 1.f + v : v; }
            curb = b; __syncthreads();
        }
        f32x4 vbuf[3][4];
#pragma unroll
        for (int pre = 0; pre < 2; ++pre) { const f32x4* xr = (const f32x4*)(xin + (size_t)(rb * 64 + wave + 8 * pre) * 1024) + lane;
#pragma unroll
            for (int j = 0; j < 4; ++j) vbuf[pre][j] = __builtin_nontemporal_load(xr + 64 * j); }
#pragma unroll
        for (int it = 0; it < 8; ++it) {
            const int row = rb * 64 + wave + 8 * it;
            if (it + 2 < 8) { const f32x4* xr = (const f32x4*)(xin + (size_t)(row + 16) * 1024) + lane;
#pragma unroll
                for (int j = 0; j < 4; ++j) vbuf[(it + 2) % 3][j] = __builtin_nontemporal_load(xr + 64 * j); }
            f32x4 v[4]; float ss = 0.f;
#pragma unroll
            for (int j = 0; j < 4; ++j) { v[j] = vbuf[it % 3][j]; ss += (v[j][0] * v[j][0] + v[j][1] * v[j][1]) + (v[j][2] * v[j][2] + v[j][3] * v[j][3]); }
            const float rstd = rsqrtf(wave_sum(ss) * (1.f / 1024.f) + EPS);
#pragma unroll
            for (int j = 0; j < 4; ++j) { const int col = 4 * lane + 256 * j;
                const f32x4 shv = *(const LAS f32x4*)(sh + col), scv = *(const LAS f32x4*)(sc + col);
                const f32x4 hv = v[j] * rstd * nw[j] * scv + shv;
                u32x2 o; o.x = pk2(hv[0], hv[1]); o.y = pk2(hv[2], hv[3]);
                *(u32x2*)(H + (size_t)row * 1024 + col) = o; asm volatile("" ::: "memory"); }
        }
    }
    __syncthreads();
}
DI const bf16* slab(const bf16* PROJ, int col64, int b) { return PROJ + ((size_t)(col64 >> 6) * M + (size_t)b * T) * 64; }
DI void rows16_load(LAS char* t, const bf16* base, int pitch, int tok0, int tstride, int lane) {
#pragma unroll
    for (int it = 0; it < 2; ++it) { const int n = lane + 64 * it, row = n >> 3, ch = n & 7;
        *(LAS u32x4*)(t + row * VT_PITCH + ch * 16) = __builtin_nontemporal_load((const u32x4*)(base + (size_t)(tok0 + tstride * row) * pitch + ch * 8)); }
}
DI void rows16_store(const LAS char* t, bf16* base, int pitch, int tok0, int tstride, int lane) {
#pragma unroll
    for (int it = 0; it < 2; ++it) { const int n = lane + 64 * it, row = n >> 3, ch = n & 7;
        *(u32x4*)(base + (size_t)(tok0 + tstride * row) * pitch + ch * 8) = *(const LAS u32x4*)(t + row * VT_PITCH + ch * 16); }
}
constexpr int KV_PITCH = 144, KV_TILE = 128 * KV_PITCH;
DI float sumsq8(bf16x8 v) { const u32x4 u = __builtin_bit_cast(u32x4, v); float s = 0.f;
#pragma unroll
    for (int i = 0; i < 4; ++i) { const float a = bflo(u[i]), b = bfhi(u[i]); s += a * a + b * b; }
    return s; }
struct SBlk { f32x4 a[2][2], b[2][2]; };
DI float alibi_c(float dkf, float pf, float nslope2, float nbound) { float t, c;
    asm("v_add_f32_e32 %0, %1, %2" : "=v"(t) : "s"(dkf), "v"(pf));
    asm("v_fma_f32 %0, |%1|, %2, %3" : "=v"(c) : "v"(t), "s"(nslope2), "v"(nbound));
    return c; }
DI void mixerB2_unit(int u, int l, const bf16* PROJ, bf16* YC, const float* dlam_l, const float* dnw_l, const float* kmax_l, LAS char* lds, int tid, int wave, int lane) {
    const int b = u >> 5, h = (u >> 3) & 3, qb = u & 7, r = lane & 15, g = lane >> 4, q = (lane & 15) >> 2, p = lane & 3;
    const bf16* kbase = slab(PROJ, C_BK + h * 64, b); const bf16* vbase = slab(PROJ, C_BV + h * 64, b);
    const bf16* qbase = slab(PROJ, C_BQ + h * 64, b); const bf16* gbase = slab(PROJ, C_BG + h * 64, b);
    const int q0w = qb * 256 + wave * 32;
    LAS char* Kb = lds; LAS char* Vb = lds + 2 * KV_TILE;
    const float slope2 = ex2(-(float)(2 * h + 2)) * LOG2E;
    __syncthreads();
    bf16x8 q1[2], q2[2]; float bound[2];
    LAS char* qs = lds + 92160 + wave * (32 * KV_PITCH);
#pragma unroll
    for (int qt = 0; qt < 2; ++qt) { const bf16* qp = qbase + (size_t)(q0w + 16 * qt + r) * 64 + 8 * g;
        q1[qt] = *(const bf16x8*)qp; q2[qt] = *(const bf16x8*)(qp + 32);
        *(LAS bf16x8*)(qs + (16 * qt + r) * KV_PITCH + 16 * g) = q1[qt]; *(LAS bf16x8*)(qs + (16 * qt + r) * KV_PITCH + 64 + 16 * g) = q2[qt]; }
    const int lrow = tid >> 3, lch = tid & 7;
    u32x4 rk = *(const u32x4*)(kbase + (size_t)lrow * 64 + lch * 8), rv = *(const u32x4*)(vbase + (size_t)lrow * 64 + lch * 8);
    u32x4 rk2 = *(const u32x4*)(kbase + (size_t)(lrow + 64) * 64 + lch * 8), rv2 = *(const u32x4*)(vbase + (size_t)(lrow + 64) * 64 + lch * 8);
    *(LAS u32x4*)(Kb + lrow * KV_PITCH + lch * 16) = rk; *(LAS u32x4*)(Vb + lrow * KV_PITCH + lch * 16) = rv;
    *(LAS u32x4*)(Kb + (lrow + 64) * KV_PITCH + lch * 16) = rk2; *(LAS u32x4*)(Vb + (lrow + 64) * KV_PITCH + lch * 16) = rv2;
    __syncthreads();
    { const float k1 = kmax_l[b * 128 + 40 + 2 * h], k2 = kmax_l[b * 128 + 41 + 2 * h];
#pragma unroll
      for (int qt = 0; qt < 2; ++qt) { float a = sumsq8(q1[qt]), c = sumsq8(q2[qt]);
          a += __shfl_xor(a, 16); a += __shfl_xor(a, 32); c += __shfl_xor(c, 16); c += __shfl_xor(c, 32);
          bound[qt] = fmaxf(sqrtf(a * k1), sqrtf(c * k2)) * 1.01f + 0.05f; } }
    f32x4 Pf;
#pragma unroll
    for (int i = 0; i < 4; ++i) Pf[i] = (float)(4 * g + i - r);
    const float nslope2s = __builtin_bit_cast(float, __builtin_amdgcn_readfirstlane(__builtin_bit_cast(int, -slope2)));
    float nbound[2] = {-bound[0], -bound[1]};
    f32x4 o1[2][4], o2[2][4], ol1[2], ol2[2];
#pragma unroll
    for (int qt = 0; qt < 2; ++qt) { ol1[qt] = (f32x4){0.f, 0.f, 0.f, 0.f}; ol2[qt] = ol1[qt];
#pragma unroll
        for (int c = 0; c < 4; ++c) { o1[qt][c] = ol1[qt]; o2[qt][c] = ol1[qt]; } }
    const bf16x8 ones = {0x3F80, 0x3F80, 0x3F80, 0x3F80, 0x3F80, 0x3F80, 0x3F80, 0x3F80};
    for (int kt128 = 0; kt128 < 16; ++kt128) {
        {
        const LAS char* K0 = Kb + (kt128 & 1) * KV_TILE; const LAS char* V0 = Vb + (kt128 & 1) * KV_TILE;
#define B_QK(S, hf_, ks_) do { const LAS char* Kc_ = K0 + (hf_) * 64 * KV_PITCH; bf16x8 qa[2], qb2[2]; \
        _Pragma("unroll") for (int qt = 0; qt < 2; ++qt) { qa[qt] = *(const LAS bf16x8*)(qs + (16 * qt + r) * KV_PITCH + 16 * g); qb2[qt] = *(const LAS bf16x8*)(qs + (16 * qt + r) * KV_PITCH + 64 + 16 * g); } \
        _Pragma("unroll") for (int kk = 0; kk < 2; ++kk) { const int kt = 2 * (ks_) + kk; \
            const bf16x8 kf1 = *(const LAS bf16x8*)(Kc_ + (16 * kt + r) * KV_PITCH + 16 * g), kf2 = *(const LAS bf16x8*)(Kc_ + (16 * kt + r) * KV_PITCH + 64 + 16 * g); \
            _Pragma("unroll") for (int qt = 0; qt < 2; ++qt) { const float dkf = (float)(128 * kt128 + 64 * (hf_) + 16 * kt - (q0w + 16 * qt)); f32x4 C; \
                _Pragma("unroll") for (int i = 0; i < 4; ++i) C[i] = alibi_c(dkf, Pf[i], nslope2s, nbound[qt]); \
                S.a[qt][kk] = MFMA16(kf1, qa[qt], C); S.b[qt][kk] = MFMA16(kf2, qb2[qt], C); } } } while (0)
#define B_SMPV(S, hf_, ks_) do { const LAS char* Vc_ = V0 + (hf_) * 64 * KV_PITCH; bf16x8 pf1[2], pf2[2]; \
        _Pragma("unroll") for (int qt = 0; qt < 2; ++qt) { \
            _Pragma("unroll") for (int kk = 0; kk < 2; ++kk) _Pragma("unroll") for (int i = 0; i < 4; ++i) { S.a[qt][kk][i] = ex2(S.a[qt][kk][i]); S.b[qt][kk][i] = ex2(S.b[qt][kk][i]); } \
            pf1[qt] = pack8(S.a[qt][0], S.a[qt][1]); pf2[qt] = pack8(S.b[qt][0], S.b[qt][1]); \
            ol1[qt] = MFMA16(ones, pf1[qt], ol1[qt]); ol2[qt] = MFMA16(ones, pf2[qt], ol2[qt]); } \
        const LAS char* v0 = Vc_ + (32 * (ks_) + 4 * g + q) * KV_PITCH + 8 * p; \
        _Pragma("unroll") for (int c = 0; c < 4; ++c) { const bf16x8 vf = cat8(vtr(v0 + 32 * c), vtr(v0 + 16 * KV_PITCH + 32 * c)); \
            _Pragma("unroll") for (int qt = 0; qt < 2; ++qt) { o1[qt][c] = MFMA16(vf, pf1[qt], o1[qt][c]); o2[qt][c] = MFMA16(vf, pf2[qt], o2[qt][c]); } } \
        __builtin_amdgcn_sched_barrier(0); } while (0)
        SBlk SA, SB;
        B_QK(SA, 0, 0); B_QK(SB, 0, 1);
        B_SMPV(SA, 0, 0);
        if (kt128 + 1 < 16) { const size_t ro = (size_t)(128 * (kt128 + 1) + lrow) * 64 + lch * 8; rk = *(const u32x4*)(kbase + ro); rv = *(const u32x4*)(vbase + ro); }
        B_QK(SA, 1, 0);
        B_SMPV(SB, 0, 1);
        B_QK(SB, 1, 1);
        if (kt128 + 1 < 16) { LAS char* Kn = Kb + ((kt128 + 1) & 1) * KV_TILE; LAS char* Vn = Vb + ((kt128 + 1) & 1) * KV_TILE;
            *(LAS u32x4*)(Kn + lrow * KV_PITCH + lch * 16) = rk; *(LAS u32x4*)(Vn + lrow * KV_PITCH + lch * 16) = rv;
            const size_t ro = (size_t)(128 * (kt128 + 1) + 64 + lrow) * 64 + lch * 8; rk = *(const u32x4*)(kbase + ro); rv = *(const u32x4*)(vbase + ro); }
        B_SMPV(SA, 1, 0);
        B_SMPV(SB, 1, 1);
#undef B_QK
#undef B_SMPV
        }
        if (kt128 + 1 < 16) { LAS char* Kn = Kb + ((kt128 + 1) & 1) * KV_TILE; LAS char* Vn = Vb + ((kt128 + 1) & 1) * KV_TILE;
            *(LAS u32x4*)(Kn + (lrow + 64) * KV_PITCH + lch * 16) = rk; *(LAS u32x4*)(Vn + (lrow + 64) * KV_PITCH + lch * 16) = rv; }
        __syncthreads();
    }
    float pa = 0.f, pb = 0.f;
    if (lane < 32) { pa = dlam_l[lane] * dlam_l[32 + lane]; pb = dlam_l[64 + lane] * dlam_l[96 + lane]; }
    pa = wave_sum(pa); pb = wave_sum(pb);
    const float lam_init = 0.8f - 0.6f * __expf(-0.3f * (float)l);
    const float lam = __expf(pa) - __expf(pb) + lam_init;
    LAS char* sc = lds + 4 * KV_TILE + wave * (16 * VT_PITCH);
#pragma unroll
    for (int qt = 0; qt < 2; ++qt) {
        const int tok0 = q0w + 16 * qt;
        const float i1 = 1.f / ol1[qt][0], i2 = lam / ol2[qt][0];
        f32x4 o[4]; float ss = 0.f;
#pragma unroll
        for (int c = 0; c < 4; ++c) { o[c] = o1[qt][c] * i1 - o2[qt][c] * i2; ss += (o[c][0] * o[c][0] + o[c][1] * o[c][1]) + (o[c][2] * o[c][2] + o[c][3] * o[c][3]); }
        ss += __shfl_xor(ss, 16); ss += __shfl_xor(ss, 32);
        const float rstd = rsqrtf(ss * (1.f / 64.f) + EPS) * (1.f - lam_init);
        rows16_load(sc, gbase, 64, tok0, 1, lane);
        u32x2 gv[4];
#pragma unroll
        for (int c = 0; c < 4; ++c) gv[c] = *(const LAS u32x2*)(sc + r * VT_PITCH + (16 * c + 4 * g) * 2);
#pragma unroll
        for (int c = 0; c < 4; ++c) { const int dd = 16 * c + 4 * g;
            const f32x4 nw = *(const f32x4*)(dnw_l + dd);
            const f32x4 y = o[c] * rstd * nw;
            u32x2 w; w.x = pk2(y[0] * silu_f(bflo(gv[c].x)), y[1] * silu_f(bfhi(gv[c].x))); w.y = pk2(y[2] * silu_f(bflo(gv[c].y)), y[3] * silu_f(bfhi(gv[c].y)));
            *(LAS u32x2*)(sc + r * VT_PITCH + dd * 2) = w; }
        rows16_store(sc, YC + (size_t)b * T * 1024 + 256 + h * 64, 1024, tok0, 1, lane);
    }
}

constexpr int KT_OFF = 32 * VT_PITCH;
struct TileRegs { u32x4 k[4]; u32x4 v[4]; };
DI void tile_load(TileRegs& R, const bf16* kb, const bf16* vb, int tokbase, int stride, int lane) {
#pragma unroll
    for (int it = 0; it < 4; ++it) { const int n = lane + 64 * it, row = n >> 3, ch = n & 7; int tok = tokbase + stride * row; tok = min(max(tok, 0), T - 1);
        R.k[it] = *(const u32x4*)(kb + (size_t)tok * 64 + ch * 8); R.v[it] = *(const u32x4*)(vb + (size_t)tok * 64 + ch * 8); }
}
DI void tile_v_to_lds(const TileRegs& R, LAS char* vt, int lane) {
#pragma unroll
    for (int it = 0; it < 4; ++it) { const int n = lane + 64 * it, row = n >> 3, ch = n & 7;
        *(LAS u32x4*)(vt + row * VT_PITCH + ch * 16) = R.v[it]; *(LAS u32x4*)(vt + KT_OFF + row * VT_PITCH + ch * 16) = R.k[it]; }
}
DI bf16x8 k_frag_at(const LAS char* kt, int t, int ks, int lane) { return *(const LAS bf16x8*)(kt + (16 * t + (lane & 15)) * VT_PITCH + 64 * ks + 16 * (lane >> 4)); }
DI bf16x8 k_frag(const LAS char* vt, int t, int ks, int lane) { return k_frag_at(vt + KT_OFF, t, ks, lane); }
constexpr int SC_OFF = 64 * VT_PITCH;
DI void fb_update(f32x4 (&o)[4], f32x4& ol, const f32x4 st0, const f32x4 st1, const LAS char* vt, int lane) {
    f32x4 p0, p1;
#pragma unroll
    for (int i = 0; i < 4; ++i) { p0[i] = ex2(st0[i]); p1[i] = ex2(st1[i]); }
    const bf16x8 pf = pack8(p0, p1);
    const bf16x8 ones = {0x3F80, 0x3F80, 0x3F80, 0x3F80, 0x3F80, 0x3F80, 0x3F80, 0x3F80};
    ol = MFMA16(ones, pf, ol);
    const int g = lane >> 4, q = (lane & 15) >> 2, p = lane & 3;
    const LAS char* v0 = vt + (4 * g + q) * VT_PITCH + 8 * p;
    const LAS char* v1 = v0 + 16 * VT_PITCH;
#pragma unroll
    for (int c = 0; c < 4; ++c) { const bf16x8 vf = cat8(vtr(v0 + 32 * c), vtr(v1 + 32 * c)); o[c] = MFMA16(vf, pf, o[c]); }
}
DI float q_norm2(const bf16x8 (&qf)[2]) { float a = sumsq8(qf[0]) + sumsq8(qf[1]); a += __shfl_xor(a, 16); a += __shfl_xor(a, 32); return a; }

DI void a_desc(int ti, int a0, int rho, int& tokbase, int& stride, int& maxd) {
    if (ti < 4) { stride = 16; tokbase = rho + 512 * ti; maxd = 1024; }
    else if (ti < 10) { stride = 4; const int m0 = 4 * a0 + (rho >> 2) - 64 + 32 * (ti - 4); tokbase = 4 * m0 + (rho & 3); maxd = 256; }
    else { stride = 1; tokbase = 16 * a0 + rho - 64 + 32 * (ti - 10); maxd = 64; }
}
template <bool EDGE>
DI void a_scores(f32x4 (&st)[2], const LAS char* kt, const bf16x8 (&qf)[2], const f32x4 cinit, int tokbase, int stride, int maxd, int tq, float nslope2, int lane) {
    const int g = lane >> 4;
    const int base0 = tokbase + stride * 4 * g - tq;
#pragma unroll
    for (int t = 0; t < 2; ++t) {
        st[t] = MFMA16(k_frag_at(kt, t, 0, lane), qf[0], cinit); st[t] = MFMA16(k_frag_at(kt, t, 1, lane), qf[1], st[t]);
#pragma unroll
        for (int i = 0; i < 4; ++i) { const int d = base0 + stride * (16 * t + i);
            bool ok = (unsigned)(d + maxd) <= (unsigned)(2 * maxd);
            if (EDGE) ok = ok && ((unsigned)(d + tq) < (unsigned)T);
            const float v = __builtin_fmaf(__builtin_fabsf((float)d), nslope2, st[t][i]);
            st[t][i] = ok ? v : -1e30f; }
    }
}
constexpr int A_V1 = 32 * VT_PITCH, A_K = 64 * VT_PITCH;
DI void a_stage(f32x4 (&st)[2], const TileRegs& R, LAS char* vt, int vpar, const bf16x8 (&qf)[2], const f32x4 cinit, int tokbase, int stride, int maxd, int tq, float nslope2, int lane) {
#pragma unroll
    for (int it = 0; it < 4; ++it) { const int n = lane + 64 * it, row = n >> 3, ch = n & 7;
        *(LAS u32x4*)(vt + vpar * A_V1 + row * VT_PITCH + ch * 16) = R.v[it]; *(LAS u32x4*)(vt + A_K + row * VT_PITCH + ch * 16) = R.k[it]; }
    a_scores<true>(st, vt + A_K, qf, cinit, tokbase, stride, maxd, tq, nslope2, lane);
}
DI void a_compute(f32x4 (&o)[4], f32x4& ol, const TileRegs& R, const bf16x8 (&qf)[2], const f32x4 cinit, int ti, int a0, int rho, int tq, float nslope2, LAS char* vt, int lane) {
    int tokbase, stride, maxd; a_desc(ti, a0, rho, tokbase, stride, maxd);
    tile_v_to_lds(R, vt, lane);
    f32x4 st[2];
    a_scores<true>(st, vt + KT_OFF, qf, cinit, tokbase, stride, maxd, tq, nslope2, lane);
    fb_update(o, ol, st[0], st[1], vt, lane);
    asm volatile("" ::: "memory");
}
DI float a_bound(const bf16x8 (&qf)[2], const float* kmax_l, int b, int h) { return sqrtf(q_norm2(qf) * (kmax_l[b * 128 + 8 + 2 * h] + kmax_l[b * 128 + 9 + 2 * h])) * 1.01f + 0.05f; }
DI void a1_compute(f32x4 (&o)[4], f32x4& ol, const TileRegs& R, const bf16x8 (&qf)[2], const f32x4 cinit, int tokbase, int tq, float nslope2, LAS char* vt, int lane) {
    tile_v_to_lds(R, vt, lane);
    f32x4 st[2];
    a_scores<true>(st, vt + KT_OFF, qf, cinit, tokbase, 1, 64, tq, nslope2, lane);
    fb_update(o, ol, st[0], st[1], vt, lane);
    asm volatile("" ::: "memory");
}
DI void mixerA1_unit(int u, const bf16* PROJ, bf16* YC, float* LPA, const float* kmax_l, LAS char* vt, int wave, int lane) {
    const int b = u >> 6, h = (u >> 4) & 3, qblk = u & 15, r = lane & 15, g = lane >> 4;
    const bf16* kb = slab(PROJ, C_AK + h * 64, b); const bf16* vb = slab(PROJ, C_AV + h * 64, b);
    const int t0 = qblk * 128 + wave * 16, tq = t0 + r;
    bf16x8 qf[2];
#pragma unroll
    for (int ks = 0; ks < 2; ++ks) qf[ks] = *(const bf16x8*)(slab(PROJ, C_AQ + h * 64, b) + (size_t)tq * 64 + 32 * ks + 8 * g);
    const float nslope2 = -ex2(-(float)(2 * h + 1)) * LOG2E;
    const float bound = a_bound(qf, kmax_l, b, h);
    const f32x4 cinit = {-bound, -bound, -bound, -bound};
    f32x4 o[4], ol = {0.f, 0.f, 0.f, 0.f};
#pragma unroll
    for (int c = 0; c < 4; ++c) o[c] = ol;
    TileRegs R0, R1, R2;
    const int tb0 = t0 - 64;
    tile_load(R0, kb, vb, tb0, 1, lane); tile_load(R1, kb, vb, tb0 + 32, 1, lane); tile_load(R2, kb, vb, tb0 + 64, 1, lane);
    f32x4 sA[2], sB[2];
    a_stage(sA, R0, vt, 0, qf, cinit, tb0, 1, 64, tq, nslope2, lane);        tile_load(R0, kb, vb, tb0 + 96, 1, lane);
    a_stage(sB, R1, vt, 1, qf, cinit, tb0 + 32, 1, 64, tq, nslope2, lane);   tile_load(R1, kb, vb, tb0 + 128, 1, lane);
    fb_update(o, ol, sA[0], sA[1], vt, lane);
    a_stage(sA, R2, vt, 0, qf, cinit, tb0 + 64, 1, 64, tq, nslope2, lane);
    fb_update(o, ol, sB[0], sB[1], vt + A_V1, lane);
    a_stage(sB, R0, vt, 1, qf, cinit, tb0 + 96, 1, 64, tq, nslope2, lane);
    fb_update(o, ol, sA[0], sA[1], vt, lane);
    a_stage(sA, R1, vt, 0, qf, cinit, tb0 + 128, 1, 64, tq, nslope2, lane);
    fb_update(o, ol, sB[0], sB[1], vt + A_V1, lane);
    fb_update(o, ol, sA[0], sA[1], vt, lane);
    LAS char* sc = vt + SC_OFF;
#pragma unroll
    for (int c = 0; c < 4; ++c) { u32x2 w; w.x = pk2(o[c][0], o[c][1]); w.y = pk2(o[c][2], o[c][3]);
        *(LAS u32x2*)(sc + r * VT_PITCH + (16 * c + 4 * g) * 2) = w; }
    rows16_store(sc, YC + (size_t)b * T * 1024 + h * 64, 1024, t0, 1, lane);
    if (g == 0) LPA[(size_t)(b * T + tq) * 4 + h] = ol[0];
}
DI void mixerA2_unit(int u, const bf16* PROJ, bf16* YC, const float* LPA, const float* kmax_l, LAS char* vt, int wave, int lane) {
    const int b = u >> 6, h = (u >> 4) & 3, rho = u & 15, a0 = 16 * wave, r = lane & 15, g = lane >> 4;
    const bf16* kb = slab(PROJ, C_AK + h * 64, b); const bf16* vb = slab(PROJ, C_AV + h * 64, b);
    const int tq = 16 * (a0 + r) + rho;
    bf16x8 qf[2];
#pragma unroll
    for (int ks = 0; ks < 2; ++ks) qf[ks] = *(const bf16x8*)(slab(PROJ, C_AQ + h * 64, b) + (size_t)tq * 64 + 32 * ks + 8 * g);
    const float nslope2 = -ex2(-(float)(2 * h + 1)) * LOG2E;
    const float bound = a_bound(qf, kmax_l, b, h);
    const f32x4 cinit = {-bound, -bound, -bound, -bound};
    f32x4 o[4], ol = {0.f, 0.f, 0.f, 0.f};
#pragma unroll
    for (int c = 0; c < 4; ++c) o[c] = ol;
    TileRegs R0, R1, R2;
#define A_LOAD(R, t_) do { int tb_, sd_, md_; a_desc((t_), a0, rho, tb_, sd_, md_); tile_load(R, kb, vb, tb_, sd_, lane); } while (0)
    A_LOAD(R0, 0); A_LOAD(R1, 1); A_LOAD(R2, 2);
    f32x4 sA[2], sB[2];
#define A_STAGE(S, R, t_) do { int tb_, sd_, md_; a_desc((t_), a0, rho, tb_, sd_, md_); a_stage(S, R, vt, (t_) & 1, qf, cinit, tb_, sd_, md_, tq, nslope2, lane); } while (0)
    A_STAGE(sA, R0, 0); A_LOAD(R0, 3);
    A_STAGE(sB, R1, 1); A_LOAD(R1, 4);
    fb_update(o, ol, sA[0], sA[1], vt, lane);
    A_STAGE(sA, R2, 2); A_LOAD(R2, 5);
    fb_update(o, ol, sB[0], sB[1], vt + A_V1, lane);
    A_STAGE(sB, R0, 3); A_LOAD(R0, 6);
    fb_update(o, ol, sA[0], sA[1], vt, lane);
    A_STAGE(sA, R1, 4); A_LOAD(R1, 7);
    fb_update(o, ol, sB[0], sB[1], vt + A_V1, lane);
    A_STAGE(sB, R2, 5); A_LOAD(R2, 8);
    fb_update(o, ol, sA[0], sA[1], vt, lane);
    A_STAGE(sA, R0, 6); A_LOAD(R0, 9);
    fb_update(o, ol, sB[0], sB[1], vt + A_V1, lane);
    A_STAGE(sB, R1, 7);
    fb_update(o, ol, sA[0], sA[1], vt, lane);
    A_STAGE(sA, R2, 8);
    fb_update(o, ol, sB[0], sB[1], vt + A_V1, lane);
    A_STAGE(sB, R0, 9);
    fb_update(o, ol, sA[0], sA[1], vt, lane);
    fb_update(o, ol, sB[0], sB[1], vt + A_V1, lane);
#undef A_STAGE
#undef A_LOAD
    const float inv = 1.f / (ol[0] + LPA[(size_t)(b * T + tq) * 4 + h]);
    LAS char* sc = vt + SC_OFF; const int tok0 = 16 * a0 + rho;
    bf16* ybase = YC + (size_t)b * T * 1024 + h * 64;
    u32x2 pv[4], gv[4];
    rows16_load(sc, ybase, 1024, tok0, 16, lane);
#pragma unroll
    for (int c = 0; c < 4; ++c) pv[c] = *(const LAS u32x2*)(sc + r * VT_PITCH + (16 * c + 4 * g) * 2);
    rows16_load(sc, slab(PROJ, C_AG + h * 64, b), 64, tok0, 16, lane);
#pragma unroll
    for (int c = 0; c < 4; ++c) gv[c] = *(const LAS u32x2*)(sc + r * VT_PITCH + (16 * c + 4 * g) * 2);
#pragma unroll
    for (int c = 0; c < 4; ++c) {
        f32x4 ov = o[c]; ov[0] += bflo(pv[c].x); ov[1] += bfhi(pv[c].x); ov[2] += bflo(pv[c].y); ov[3] += bfhi(pv[c].y); ov = ov * inv;
        u32x2 w; w.x = pk2(ov[0] * silu_f(bflo(gv[c].x)), ov[1] * silu_f(bfhi(gv[c].x))); w.y = pk2(ov[2] * silu_f(bflo(gv[c].y)), ov[3] * silu_f(bfhi(gv[c].y)));
        *(LAS u32x2*)(sc + r * VT_PITCH + (16 * c + 4 * g) * 2) = w; }
    rows16_store(sc, ybase, 1024, tok0, 16, lane);
}
DI void d_compute(f32x4 (&o)[4], f32x4& ol, const TileRegs& R, const bf16x8 (&qf)[2], const f32x4 cinit, int kr, int kc0, const LAS float* rpl, LAS char* vt, int lane) {
    tile_v_to_lds(R, vt, lane);
    const LAS float* rr_ = rpl + kr * 31;
    f32x4 st[2];
#pragma unroll
    for (int t = 0; t < 2; ++t) {
        st[t] = MFMA16(k_frag(vt, t, 0, lane), qf[0], cinit); st[t] = MFMA16(k_frag(vt, t, 1, lane), qf[1], st[t]);
#pragma unroll
        for (int i = 0; i < 4; ++i) { const bool ok = (unsigned)(kc0 + 16 * t + i) <= 15u;
            const float v = st[t][i] + rr_[16 * t + i];
            st[t][i] = ok ? v : -1e30f; }
    }
    fb_update(o, ol, st[0], st[1], vt, lane);
    asm volatile("" ::: "memory");
}
DI float d_stage_rpb(const float* rpb_l, int h, LAS char* vt, int lane) {
    LAS float* rp = (LAS float*)(vt + 12288); float rmax = 0.f;
    for (int i = lane; i < 15 * 31; i += 64) { const float v = rpb_l[h * 465 + i] * LOG2E; rp[i] = v; rmax = fmaxf(rmax, fabsf(v)); }
#pragma unroll
    for (int o_ = 1; o_ < 64; o_ <<= 1) rmax = fmaxf(rmax, __shfl_xor(rmax, o_));
    return rmax;
}
DI void mixerD2_unit(int u, const bf16* PROJ, bf16* YC, float rmax, const float* kmax_l, LAS char* vt, int wave, int lane) {
    const int b = u >> 6, h = (u >> 4) & 3, wu = (u & 15) * 8 + wave, rr = wu >> 2, cb = wu & 3, r = lane & 15, g = lane >> 4;
    const bf16* kb = slab(PROJ, C_DK + h * 64, b); const bf16* vb = slab(PROJ, C_DV + h * 64, b);
    const int qcol = 16 * cb + r, tq = 64 * rr + qcol;
    const int cs = min(max(qcol - 8, 0), 48), rs = min(max(rr - 4, 0), 24), c0 = min(max(16 * cb - 8, 0), 32);
    LAS float* rp = (LAS float*)(vt + 12288);
    bf16x8 qf[2];
#pragma unroll
    for (int ks = 0; ks < 2; ++ks) qf[ks] = *(const bf16x8*)(slab(PROJ, C_DQ + h * 64, b) + (size_t)tq * 64 + 32 * ks + 8 * g);
    const float bound = sqrtf(q_norm2(qf) * (kmax_l[b * 128 + 104 + 2 * h] + kmax_l[b * 128 + 105 + 2 * h])) * 1.01f + 0.05f + rmax;
    const f32x4 cinit = {-bound, -bound, -bound, -bound};
    f32x4 o[4], ol = {0.f, 0.f, 0.f, 0.f};
#pragma unroll
    for (int c = 0; c < 4; ++c) o[c] = ol;
    const int tb0 = 64 * rs + c0, dr0 = rs - rr + 7;
    const int kc0 = c0 + 4 * g - cs;
    const LAS float* rpl = rp + dr0 * 31 + (c0 + 4 * g - qcol + 15);
    TileRegs R0, R1, R2;
    tile_load(R0, kb, vb, tb0, 1, lane); tile_load(R1, kb, vb, tb0 + 64, 1, lane); tile_load(R2, kb, vb, tb0 + 128, 1, lane);
    d_compute(o, ol, R0, qf, cinit, 0, kc0, rpl, vt, lane); tile_load(R0, kb, vb, tb0 + 192, 1, lane);
    d_compute(o, ol, R1, qf, cinit, 1, kc0, rpl, vt, lane); tile_load(R1, kb, vb, tb0 + 256, 1, lane);
    d_compute(o, ol, R2, qf, cinit, 2, kc0, rpl, vt, lane); tile_load(R2, kb, vb, tb0 + 320, 1, lane);
    d_compute(o, ol, R0, qf, cinit, 3, kc0, rpl, vt, lane); tile_load(R0, kb, vb, tb0 + 384, 1, lane);
    d_compute(o, ol, R1, qf, cinit, 4, kc0, rpl, vt, lane); tile_load(R1, kb, vb, tb0 + 448, 1, lane);
    d_compute(o, ol, R2, qf, cinit, 5, kc0, rpl, vt, lane);
    d_compute(o, ol, R0, qf, cinit, 6, kc0, rpl, vt, lane);
    d_compute(o, ol, R1, qf, cinit, 7, kc0, rpl, vt, lane);
    const float inv = 1.f / ol[0];
    LAS char* sc = vt + SC_OFF; const int tok0 = 64 * rr + 16 * cb;
    u32x2 gv[4];
    rows16_load(sc, slab(PROJ, C_DG + h * 64, b), 64, tok0, 1, lane);
#pragma unroll
    for (int c = 0; c < 4; ++c) gv[c] = *(const LAS u32x2*)(sc + r * VT_PITCH + (16 * c + 4 * g) * 2);
#pragma unroll
    for (int c = 0; c < 4; ++c) { const f32x4 ov = o[c] * inv;
        u32x2 w; w.x = pk2(ov[0] * silu_f(bflo(gv[c].x)), ov[1] * silu_f(bfhi(gv[c].x))); w.y = pk2(ov[2] * silu_f(bflo(gv[c].y)), ov[3] * silu_f(bfhi(gv[c].y)));
        *(LAS u32x2*)(sc + r * VT_PITCH + (16 * c + 4 * g) * 2) = w; }
    rows16_store(sc, YC + (size_t)b * T * 1024 + 768 + h * 64, 1024, tok0, 1, lane);
}
DI void conv_image(LAS char* img, const bf16* PROJ, int b, int t0, int chan0, const float* cw, const float* cb, int item) {
    const int cgp = item & 15, tg = item >> 4, ch = chan0 + cgp * 8, tb = t0 + tg * 8;
    const bf16* base = slab(PROJ, (C_CX + ch) & ~63, b) + ((C_CX + ch) & 63);
    float w[5][8], o[8][8];
#pragma unroll
    for (int k = 0; k < 5; ++k) { const f32x4 a = *(const f32x4*)(cw + k * 768 + ch), c = *(const f32x4*)(cw + k * 768 + ch + 4);
#pragma unroll
        for (int e = 0; e < 4; ++e) { w[k][e] = a[e]; w[k][4 + e] = c[e]; } }
    { const f32x4 a = *(const f32x4*)(cb + ch), c = *(const f32x4*)(cb + ch + 4);
#pragma unroll
      for (int oi = 0; oi < 8; ++oi)
#pragma unroll
          for (int e = 0; e < 4; ++e) { o[oi][e] = a[e]; o[oi][4 + e] = c[e]; } }
#pragma unroll
    for (int ri = 0; ri < 12; ++ri) {
        const int t = tb - 2 + ri;
        u32x4 v = (u32x4){0u, 0u, 0u, 0u};
        if (t >= 0 && t < T) v = *(const u32x4*)(base + (size_t)t * 64);
        float in[8] = {bflo(v.x), bfhi(v.x), bflo(v.y), bfhi(v.y), bflo(v.z), bfhi(v.z), bflo(v.w), bfhi(v.w)};
#pragma unroll
        for (int k = 0; k < 5; ++k) { const int oi = ri - k;
            if (oi >= 0 && oi < 8) {
#pragma unroll
                for (int e = 0; e < 8; ++e) o[oi][e] += w[k][e] * in[e]; } }
    }
#pragma unroll
    for (int oi = 0; oi < 8; ++oi) { u32x4 pk; pk.x = pk2(silu_f(o[oi][0]), silu_f(o[oi][1])); pk.y = pk2(silu_f(o[oi][2]), silu_f(o[oi][3]));
        pk.z = pk2(silu_f(o[oi][4]), silu_f(o[oi][5])); pk.w = pk2(silu_f(o[oi][6]), silu_f(o[oi][7]));
        *(LAS u32x4*)(img + (tg * 8 + oi) * IMG_PITCH + cgp * 16) = pk; }
}
template <bool AUXW>
DI void decay_tables(LAS float* gtab, LAS float* aux, const float* DT, const float* a_log_l, float* TOT, int b, int c, int grp, int combo, int lane) {
    const int hh = combo >> 1, dir = combo & 1, h = 2 * grp + hh;
    const float A = -__expf(a_log_l[dir * 4 + h]);
    const size_t row = (size_t)b * T + c * 128 + 2 * lane;
    const float dt0 = DT[row * 8 + dir * 4 + h], dt1 = DT[(row + 1) * 8 + dir * 4 + h];
    const float a0 = A * dt0, a1 = A * dt1;
    float s = a0 + a1;
#pragma unroll
    for (int o = 1; o < 64; o <<= 1) { const float v = __shfl_up(s, o); if (lane >= o) s += v; }
    const float tot = __shfl(s, 63);
    float g0, g1;
    if (dir == 0) { g1 = s; g0 = s - a1; } else { g0 = tot - (s - a1) + a0; g1 = tot - s + a1; }
    gtab[combo * 128 + 2 * lane] = g0; gtab[combo * 128 + 2 * lane + 1] = g1;
    if (AUXW) { aux[combo * 128 + 2 * lane] = dt0 * __expf(tot - g0); aux[combo * 128 + 2 * lane + 1] = dt1 * __expf(tot - g1);
        if (lane == 0) TOT[((b * 16 + c) * 4 + h) * 2 + dir] = tot; }
    else { aux[combo * 128 + 2 * lane] = dt0; aux[combo * 128 + 2 * lane + 1] = dt1; }
}
DI void ssd_part1_unit(int u, const bf16* PROJ, float* DT, const bf16* H, const bf16* wdtb_l, const float* dt_bias_l, const float* cw, const float* cb, const float* a_log_l, float* STATES, float* TOT,
                       LAS unsigned char* ldsu, int tid, int wave, int lane) {
    const int b = u >> 5, c = (u >> 1) & 15, grp = u & 1, t0 = c * 128;
    LAS char* lds = (LAS char*)ldsu;
    LAS char* XS = lds; LAS char* BM = lds + IMG_BYTES;
    LAS float* gtab = (LAS float*)(lds + 3 * IMG_BYTES); LAS float* wtab = gtab + 512;
    const int r = lane & 15, g = lane >> 4, q = (lane & 15) >> 2, p = lane & 3;
    __syncthreads();
    {
        LAS char* wl = lds + 3 * IMG_BYTES + 4096;
        LAS char* hst = lds + 2 * IMG_BYTES + wave * (16 * IMG_PITCH);
        for (int i = tid; i < 1024; i += 512) { const int row = i >> 7, ch = i & 127; *(LAS u32x4*)(wl + row * 2064 + ch * 16) = *(const u32x4*)(wdtb_l + (size_t)row * 1024 + ch * 8); }
        __syncthreads();
        f32x4 dacc = {0.f, 0.f, 0.f, 0.f};
        const bf16* hrow = H + (size_t)(b * T + t0 + 16 * wave) * 1024;
        u32x4 hv[4];
#pragma unroll
        for (int it = 0; it < 4; ++it) { const int n = lane + 64 * it; hv[it] = *(const u32x4*)(hrow + (size_t)(n >> 4) * 1024 + (n & 15) * 8); }
        for (int ck = 0; ck < 8; ++ck) {
#pragma unroll
            for (int it = 0; it < 4; ++it) { const int n = lane + 64 * it; *(LAS u32x4*)(hst + (n >> 4) * IMG_PITCH + (n & 15) * 16) = hv[it]; }
            if (ck + 1 < 8) {
#pragma unroll
                for (int it = 0; it < 4; ++it) { const int n = lane + 64 * it; hv[it] = *(const u32x4*)(hrow + (size_t)(n >> 4) * 1024 + (ck + 1) * 128 + (n & 15) * 8); } }
#pragma unroll
            for (int ks = 0; ks < 4; ++ks) {
                const bf16x8 af = *(const LAS bf16x8*)(hst + r * IMG_PITCH + 64 * ks + 16 * g);
                bf16x8 bfw = {0, 0, 0, 0, 0, 0, 0, 0};
                if (r < 8) bfw = *(const LAS bf16x8*)(wl + r * 2064 + (ck * 128 + 32 * ks + 8 * g) * 2);
                dacc = MFMA16(af, bfw, dacc);
            }
            asm volatile("" ::: "memory");
        }
        if (r < 8) { const float bias = dt_bias_l[r];
#pragma unroll
            for (int i = 0; i < 4; ++i) { const float xx = dacc[i] + bias; DT[(size_t)(b * T + t0 + 16 * wave + 4 * g + i) * 8 + r] = xx > 20.f ? xx : log1pf(__expf(xx)); } }
    }
    __syncthreads();
    { const int img = tid >> 8; conv_image(img ? BM : XS, PROJ, b, t0, img ? 256 + grp * 128 : grp * 128, cw, cb, tid & 255); }
    asm volatile("s_waitcnt vmcnt(0)" ::: "memory");
    __syncthreads();
    if (wave < 4) decay_tables<true>(gtab, wtab, DT, a_log_l, TOT, b, c, grp, wave, lane);
    __syncthreads();
    bf16x8 bfr[4];
#pragma unroll
    for (int ks = 0; ks < 4; ++ks) { const LAS char* bp = BM + (32 * ks + 8 * g + q) * IMG_PITCH + 32 * wave + 8 * p; bfr[ks] = cat8(vtr(bp), vtr(bp + 4 * IMG_PITCH)); }
#pragma unroll
    for (int combo = 0; combo < 4; ++combo) {
        const int hh = combo >> 1, dir = combo & 1, h = 2 * grp + hh;
        f32x4 acc[4];
#pragma unroll
        for (int pt = 0; pt < 4; ++pt) acc[pt] = (f32x4){0.f, 0.f, 0.f, 0.f};
#pragma unroll
        for (int ks = 0; ks < 4; ++ks) {
            const f32x4 w0 = *(const LAS f32x4*)(wtab + combo * 128 + 32 * ks + 8 * g), w1 = *(const LAS f32x4*)(wtab + combo * 128 + 32 * ks + 8 * g + 4);
#pragma unroll
            for (int pt = 0; pt < 4; ++pt) {
                const LAS char* xp = XS + (32 * ks + 8 * g + q) * IMG_PITCH + (hh * 64 + 16 * pt) * 2 + 8 * p;
                const u32x2 lo = __builtin_bit_cast(u32x2, vtr(xp)), hi = __builtin_bit_cast(u32x2, vtr(xp + 4 * IMG_PITCH));
                u32x4 af; af.x = pk2(bflo(lo.x) * w0[0], bfhi(lo.x) * w0[1]); af.y = pk2(bflo(lo.y) * w0[2], bfhi(lo.y) * w0[3]);
                af.z = pk2(bflo(hi.x) * w1[0], bfhi(hi.x) * w1[1]); af.w = pk2(bflo(hi.y) * w1[2], bfhi(hi.y) * w1[3]);
                acc[pt] = MFMA16(__builtin_bit_cast(bf16x8, af), bfr[ks], acc[pt]);
            }
        }
        float* sb = STATES + ((size_t)(((b * 16 + c) * 4 + h) * 2 + dir) * 64) * 128;
#pragma unroll
        for (int pt = 0; pt < 4; ++pt)
#pragma unroll
            for (int i = 0; i < 4; ++i) sb[(size_t)(16 * pt + 4 * g + i) * 128 + 16 * wave + r] = acc[pt][i];
    }
}
DI void ssd_scan(float* STATES, const float* TOT, int gtid, int gthreads) {
    for (int it = gtid; it < 8 * 4 * 2 * 64 * 32; it += gthreads) {
        const int n4 = it & 31, p = (it >> 5) & 63, dir = (it >> 11) & 1, h = (it >> 12) & 3, b = it >> 14;
        f32x4 v[16]; float e[16];
#pragma unroll
        for (int st = 0; st < 16; ++st) { const int c = dir ? 15 - st : st; const int hd = ((b * 16 + c) * 4 + h) * 2 + dir;
            v[st] = *(const f32x4*)(STATES + ((size_t)hd * 64 + p) * 128 + n4 * 4); e[st] = __expf(TOT[hd]); }
        f32x4 carry = (f32x4){0.f, 0.f, 0.f, 0.f};
#pragma unroll
        for (int st = 0; st < 16; ++st) { const int c = dir ? 15 - st : st; const int hd = ((b * 16 + c) * 4 + h) * 2 + dir;
            *(f32x4*)(STATES + ((size_t)hd * 64 + p) * 128 + n4 * 4) = carry; carry = carry * e[st] + v[st]; }
    }
}
DI void ssd_part2_unit(int u, const bf16* PROJ, const float* DT, const float* cw, const float* cb, const float* a_log_l, const float* dskip_l, const float* snw_l,
                       const float* STATES, bf16* YC, LAS unsigned char* ldsu, int tid, int wave, int lane) {
    const int b = u >> 5, c = (u >> 1) & 15, grp = u & 1, t0 = c * 128;
    LAS char* lds = (LAS char*)ldsu;
    LAS char* XS = lds; LAS char* BM = lds + IMG_BYTES; LAS char* CM = lds + 2 * IMG_BYTES;
    LAS float* gtab = (LAS float*)(lds + 3 * IMG_BYTES); LAS float* dttab = gtab + 512;
    __syncthreads();
    if (tid < 256) conv_image(CM, PROJ, b, t0, 512 + grp * 128, cw, cb, tid);
    if (wave >= 4) decay_tables<false>(gtab, dttab, DT, a_log_l, nullptr, b, c, grp, wave - 4, lane);
#pragma unroll 4
    for (int k = 0; k < 16; ++k) { const int idx = tid + 512 * k, combo = idx >> 11, within = idx & 2047, pp = within >> 5, n4 = within & 31;
        const int hh = combo >> 1, dir = combo & 1, h = 2 * grp + hh;
        const f32x4 sv = *(const f32x4*)(STATES + ((size_t)(((b * 16 + c) * 4 + h) * 2 + dir) * 64 + pp) * 128 + n4 * 4);
        u32x2 w; w.x = pk2(sv[0], sv[1]); w.y = pk2(sv[2], sv[3]);
        *(LAS u32x2*)(lds + combo * (64 * IMG_PITCH) + pp * IMG_PITCH + n4 * 8) = w; }
    __syncthreads();
    const int r = lane & 15, g = lane >> 4, q = (lane & 15) >> 2, p = lane & 3;
    const int l0 = 16 * wave, lq = l0 + r;
    bf16x8 cq[4];
#pragma unroll
    for (int ks = 0; ks < 4; ++ks) cq[ks] = *(const LAS bf16x8*)(CM + lq * IMG_PITCH + 64 * ks + 16 * g);
    f32x4 acc[2][4];
#pragma unroll
    for (int hh = 0; hh < 2; ++hh)
#pragma unroll
        for (int pt = 0; pt < 4; ++pt) acc[hh][pt] = (f32x4){0.f, 0.f, 0.f, 0.f};
#pragma unroll
    for (int combo = 0; combo < 4; ++combo) {
        const int hh = combo >> 1;
        const float eg = __expf(gtab[combo * 128 + lq]);
#pragma unroll
        for (int pt = 0; pt < 4; ++pt) {
            f32x4 tmp = (f32x4){0.f, 0.f, 0.f, 0.f};
#pragma unroll
            for (int ks = 0; ks < 4; ++ks) { const bf16x8 af = *(const LAS bf16x8*)(lds + combo * (64 * IMG_PITCH) + (16 * pt + r) * IMG_PITCH + 64 * ks + 16 * g); tmp = MFMA16(af, cq[ks], tmp); }
            acc[hh][pt] += tmp * eg;
        }
    }
    __syncthreads();
    { const int img = tid >> 8; conv_image(lds + img * IMG_BYTES, PROJ, b, t0, img * 256 + grp * 128, cw, cb, tid & 255); }
    __syncthreads();
    for (int st = 0; st < 4; ++st) {
        f32x4 gt[2];
#pragma unroll
        for (int t = 0; t < 2; ++t) { gt[t] = (f32x4){0.f, 0.f, 0.f, 0.f};
#pragma unroll
            for (int ks = 0; ks < 4; ++ks) { const bf16x8 bf = *(const LAS bf16x8*)(BM + (32 * st + 16 * t + r) * IMG_PITCH + 64 * ks + 16 * g); gt[t] = MFMA16(bf, cq[ks], gt[t]); } }
#pragma unroll
        for (int combo = 0; combo < 4; ++combo) {
            const int hh = combo >> 1, dir = combo & 1;
            const bool need = dir == 0 ? (32 * st <= l0 + 15) : (32 * st + 31 >= l0);
            if (need) {
                const float gl = gtab[combo * 128 + lq];
                f32x4 mm[2];
#pragma unroll
                for (int t = 0; t < 2; ++t) { const int sbase = 32 * st + 16 * t + 4 * g;
                    const f32x4 gs = *(const LAS f32x4*)(gtab + combo * 128 + sbase), ds = *(const LAS f32x4*)(dttab + combo * 128 + sbase);
#pragma unroll
                    for (int i = 0; i < 4; ++i) { const int se = sbase + i; const bool ok = dir == 0 ? (se <= lq) : (se >= lq);
                        const float e = __expf(fminf(gl - gs[i], 0.f)); mm[t][i] = ok ? gt[t][i] * e * ds[i] : 0.f; } }
                const bf16x8 pf = pack8(mm[0], mm[1]);
#pragma unroll
                for (int pt = 0; pt < 4; ++pt) { const LAS char* xp = XS + (32 * st + 4 * g + q) * IMG_PITCH + (hh * 64 + 16 * pt) * 2 + 8 * p;
                    acc[hh][pt] = MFMA16(cat8(vtr(xp), vtr(xp + 16 * IMG_PITCH)), pf, acc[hh][pt]); }
            }
        }
    }
    const int token = t0 + lq; float ss = 0.f;
#pragma unroll
    for (int hh = 0; hh < 2; ++hh) { const float dsk = dskip_l[2 * grp + hh];
#pragma unroll
        for (int pt = 0; pt < 4; ++pt) { const int ch = hh * 64 + 16 * pt + 4 * g;
            const u32x2 xv = *(const LAS u32x2*)(XS + lq * IMG_PITCH + ch * 2);
            const u32x2 zv = __builtin_nontemporal_load((const u32x2*)(slab(PROJ, C_CZ + grp * 128 + hh * 64, b) + (size_t)token * 64 + 16 * pt + 4 * g));
            f32x4 y = acc[hh][pt];
            y[0] = (y[0] + dsk * bflo(xv.x)) * silu_f(bflo(zv.x)); y[1] = (y[1] + dsk * bfhi(xv.x)) * silu_f(bfhi(zv.x));
            y[2] = (y[2] + dsk * bflo(xv.y)) * silu_f(bflo(zv.y)); y[3] = (y[3] + dsk * bfhi(xv.y)) * silu_f(bfhi(zv.y));
            acc[hh][pt] = y; ss += (y[0] * y[0] + y[1] * y[1]) + (y[2] * y[2] + y[3] * y[3]); } }
    ss += __shfl_xor(ss, 16); ss += __shfl_xor(ss, 32);
    const float rstd = rsqrtf(ss * (1.f / 128.f) + EPS);
#pragma unroll
    for (int hh = 0; hh < 2; ++hh)
#pragma unroll
        for (int pt = 0; pt < 4; ++pt) { const int ch = grp * 128 + hh * 64 + 16 * pt + 4 * g;
            const f32x4 nw = *(const f32x4*)(snw_l + ch); const f32x4 y = acc[hh][pt] * rstd * nw;
            u32x2 w; w.x = pk2(y[0], y[1]); w.y = pk2(y[2], y[3]);
            *(u32x2*)(YC + (size_t)(b * T + token) * 1024 + 512 + ch) = w; }
}

DI void phase_final(float* xo, const float* fw, int tid, int G) {
    const int lane = tid & 63, wave = tid >> 6;
    f32x4 nw[4];
#pragma unroll
    for (int j = 0; j < 4; ++j) nw[j] = *(const f32x4*)(fw + 4 * lane + 256 * j);
    const int stride = G * 8, nrow = (M - (blockIdx.x * 8 + wave) + stride - 1) / stride;
    const int row0 = blockIdx.x * 8 + wave;
    f32x4 vb[3][4];
#pragma unroll
    for (int pre = 0; pre < 2; ++pre) if (pre < nrow) { const f32x4* xr = (const f32x4*)(xo + (size_t)(row0 + pre * stride) * 1024) + lane;
#pragma unroll
        for (int j = 0; j < 4; ++j) vb[pre][j] = xr[64 * j]; }
    for (int it0 = 0; it0 < nrow; it0 += 3) {
#pragma unroll
        for (int k = 0; k < 3; ++k) { const int it = it0 + k;
            if (it < nrow) {
                if (it + 2 < nrow) { const f32x4* xn = (const f32x4*)(xo + (size_t)(row0 + (it + 2) * stride) * 1024) + lane;
#pragma unroll
                    for (int j = 0; j < 4; ++j) vb[(k + 2) % 3][j] = xn[64 * j]; }
                f32x4* xr = (f32x4*)(xo + (size_t)(row0 + it * stride) * 1024) + lane;
                f32x4 v[4]; float ss = 0.f;
#pragma unroll
                for (int j = 0; j < 4; ++j) { v[j] = vb[k][j]; ss += (v[j][0] * v[j][0] + v[j][1] * v[j][1]) + (v[j][2] * v[j][2] + v[j][3] * v[j][3]); }
                const float rstd = rsqrtf(wave_sum(ss) * (1.f / 1024.f) + EPS);
#pragma unroll
                for (int j = 0; j < 4; ++j) xr[64 * j] = v[j] * rstd * nw[j];
            } }
    }
}

#ifndef EN_P0
#define EN_P0 1
#endif
#ifndef EN_P1
#define EN_P1 1
#endif
#ifndef EN_G1
#define EN_G1 1
#endif
#ifndef EN_B
#define EN_B 1
#endif
#ifndef EN_S1
#define EN_S1 1
#endif
#ifndef EN_A
#define EN_A 1
#endif
#ifndef EN_D
#define EN_D 1
#endif
#ifndef EN_SCAN
#define EN_SCAN 1
#endif
#ifndef EN_S2
#define EN_S2 1
#endif
#ifndef EN_G2
#define EN_G2 1
#endif
#ifndef EN_FIN
#define EN_FIN 1
#endif
#define XB_TMO      128
#define XB_XCNT(j)  (256  + 64 * (j))
#define XB_XSUB(j)  (1280 + 64 * (j))
#define XB_XGEN(j)  (2304 + 64 * (j))
#define XB_TOP      3328
#define XB_TOPGEN   3392
#define XCD_BAR_WORDS 3456
#define XB_SPIN_CAP (1u << 18)

__device__ __forceinline__ unsigned xb_ld(unsigned* p)              { return __hip_atomic_load(p, __ATOMIC_RELAXED, __HIP_MEMORY_SCOPE_AGENT); }
__device__ __forceinline__ unsigned xb_add(unsigned* p, unsigned v) { return __hip_atomic_fetch_add(p, v, __ATOMIC_RELAXED, __HIP_MEMORY_SCOPE_AGENT); }
__device__ __forceinline__ unsigned xb_xcc_id() { return (unsigned)__builtin_amdgcn_s_getreg((3 << 11) | 20) & 0xFu; }
#define XB_SPIN(cond, bar) do { unsigned _sp = 0; while (cond) { __builtin_amdgcn_s_sleep(1); \
    if ((++_sp & 255u) == 0u) { if (xb_ld(&(bar)[XB_TMO])) break; if (_sp > XB_SPIN_CAP) { atomicAdd(&(bar)[XB_TMO], 1u); break; } } } } while (0)

struct XcdBarrier {
    unsigned* bar; unsigned x;
    volatile LAS unsigned* st;
};

__device__ __forceinline__ XcdBarrier xcd_barrier_post(unsigned* bar, volatile LAS unsigned* st) {
    XcdBarrier b; b.bar = bar; b.x = xb_xcc_id(); b.st = st;
    if (threadIdx.x == 0) (void)xb_add(&bar[XB_XCNT(b.x)], 1u);
    return b;
}
__device__ __forceinline__ void xcd_barrier_complete(unsigned* bar, unsigned x, unsigned& nloc, unsigned& nx) {
    const unsigned G = gridDim.x * gridDim.y * gridDim.z;
    unsigned sum, cnt, mine, sp = 0u;
    for (;;) {
        sum = 0u; cnt = 0u; mine = 0u;
#pragma unroll
        for (unsigned j = 0; j < 16; ++j) { const unsigned c = xb_ld(&bar[XB_XCNT(j)]); sum += c; cnt += (c > 0u) ? 1u : 0u; mine = (j == x) ? c : mine; }
        if (sum == G) break;
        __builtin_amdgcn_s_sleep(1);
        if ((++sp & 255u) == 0u) { if (xb_ld(&bar[XB_TMO])) break; if (sp > XB_SPIN_CAP) { atomicAdd(&bar[XB_TMO], 1u); break; } }
    }
    nloc = mine > 0u ? mine : 1u; nx = cnt > 0u ? cnt : 1u;
}

__device__ __forceinline__ void xcd_barrier(const XcdBarrier& b) {
    asm volatile("s_waitcnt vmcnt(0)" ::: "memory");
    __syncthreads();
    if (threadIdx.x == 0) {
        unsigned* bar = b.bar;
        __builtin_amdgcn_s_waitcnt(0);
        unsigned nloc = b.st[0], nx = b.st[1];
        if (nloc == 0u) { xcd_barrier_complete(bar, b.x, nloc, nx); b.st[0] = nloc; b.st[1] = nx; }
        const unsigned old = xb_add(&bar[XB_XSUB(b.x)], 1u);
        const unsigned gen = old / nloc;
        if (old + 1u == (gen + 1u) * nloc) {
            __builtin_amdgcn_fence(__ATOMIC_RELEASE, "agent");
            asm volatile("s_waitcnt vmcnt(0)" ::: "memory");
            const unsigned og = xb_add(&bar[XB_TOP], 1u);
            const unsigned tg = og / nx;
            if (og + 1u == (tg + 1u) * nx) xb_add(&bar[XB_TOPGEN], 1u);
            else XB_SPIN(xb_ld(&bar[XB_TOPGEN]) == tg, bar);
            __builtin_amdgcn_fence(__ATOMIC_ACQUIRE, "agent");
            xb_add(&bar[XB_XGEN(b.x)], 1u);
            asm volatile("s_waitcnt vmcnt(0)" ::: "memory");
        } else {
            XB_SPIN(xb_ld(&bar[XB_XGEN(b.x)]) == gen, bar);
            __builtin_amdgcn_fence(__ATOMIC_ACQUIRE, "agent");
            asm volatile("s_waitcnt vmcnt(0)" ::: "memory");
        }
    }
    __syncthreads();
}

DI int hw_lane() { int l_; asm volatile("v_mbcnt_lo_u32_b32 %0, -1, 0\n\tv_mbcnt_hi_u32_b32 %0, -1, %0" : "=v"(l_)); return l_; }
struct Args { const float* in[17]; float* out; unsigned char* ws; int ph_lo, ph_hi; };
__global__ void __launch_bounds__(512) fwd_kernel(Args a) {
    extern __shared__ __attribute__((aligned(16))) unsigned char lds_raw[];
    cg::grid_group grid = cg::this_grid();
    LAS unsigned char* lds = (LAS unsigned char*)lds_raw;
    const int wave0 = __builtin_amdgcn_readfirstlane(threadIdx.x >> 6), G = gridDim.x;
#define TID0() (wave0 * 64 + hw_lane())
    const int lo = a.ph_lo, hi = a.ph_hi;
    if (hi > 1000) grid.sync();
    volatile LAS unsigned* bst = (volatile LAS unsigned*)(lds + 131072);
    if (TID0() < 16) bst[TID0()] = 0u;
    __syncthreads();
    XcdBarrier bar = xcd_barrier_post((unsigned*)(a.ws + WS_BAR), bst);
    unsigned char* ws = a.ws;
    bf16* WIN = (bf16*)(ws + WS_WIN); bf16* WOUT = (bf16*)(ws + WS_WOUT); float* MODP = (float*)(ws + WS_MODP); float* DT = (float*)(ws + WS_DT);
    float* TOT = (float*)(ws + WS_TOT); float* KMAX = (float*)(ws + WS_KMAX); bf16* WDT = (bf16*)(ws + WS_WDT); float* MODF = (float*)(ws + WS_MODF); float* LPA = (float*)(ws + WS_LPA); bf16* H = (bf16*)(ws + WS_H); bf16* YC = (bf16*)(ws + WS_YC); bf16* PROJ = (bf16*)(ws + WS_PROJ); float* STATES = (float*)(ws + WS_ST);
#define IN(k) (lo <= (k) && (k) < hi)
#define LAUNDER() int tp = TID0(); const int tid = tp, lane = tp & 63, wave = __builtin_amdgcn_readfirstlane(tp >> 6); (void)tid; (void)lane; (void)wave
#define SEAM(k) do { if (lo <= (k) && (k) + 1 < hi) { XcdBarrier b2_ = bar; asm volatile("" : "+s"(b2_.bar)); xcd_barrier(b2_); } } while (0)
    if (IN(0) && EN_P0) { LAUNDER(); phase0(a.in[1], a.in[3], a.in[5], a.in[15], WIN, WOUT, MODP, KMAX, WDT, lds, tid, G); }
    SEAM(0);
    for (int l = 0; l < 2; ++l) {
        const int pb = 1 + 6 * l;
        const float* modp = MODP + (size_t)l * 8 * 8 * 3072; const float* adab = a.in[4] + l * 3072;
        const float* xin = l == 0 ? a.in[0] : a.out;
        const bool fusedp = (G == 256);
        if (!(l == 1 && fusedp)) { if (IN(pb) && EN_P1) { LAUNDER(); phase_modulate(xin, a.in[2] + l * 1024, modp, adab, H, lds, tid, G, l == 0 ? MODF : nullptr, MODP, a.in[4]); }
            SEAM(pb); }
        if (IN(pb + 1) && EN_G1) { LAUNDER();
            pg8::Gemm g{H, WIN + (size_t)l * NP * 1024, M, NP, 1024}; pg8::StaticOrder S; S.init(M, NP, G, (int)blockIdx.x);
            pg8::EpiProj E{PROJ, (unsigned*)(KMAX + l * 1024), lds + 131072 + 1024};
            pg8::gemm_phase<pg8::EpiProj, pg8::StaticOrder, true, true>(lds, g, S, E, tp);
        }
        SEAM(pb + 1);
        if (IN(pb + 2)) {
            if (EN_B) { LAUNDER(); LAS char* vt = (LAS char*)lds + wave * 16384;
                (void)vt; for (int u = blockIdx.x; u < 256; u += G) { mixerB2_unit(u, l, PROJ, YC, a.in[6] + l * 128, a.in[7] + l * 64, KMAX + l * 1024, (LAS char*)lds, tid, wave, lane); } __syncthreads(); }
            if (EN_S1) { LAUNDER(); __syncthreads();
                for (int u = blockIdx.x; u < 256; u += G) ssd_part1_unit(u, PROJ, DT, H, WDT + l * 16384, a.in[11] + l * 8, a.in[8] + l * 5 * 768, a.in[9] + l * 768, a.in[10] + l * 8, STATES, TOT, lds, tid, wave, lane);
                __syncthreads(); }
            if (EN_A) { LAUNDER(); LAS char* vt = (LAS char*)lds + wave * 16384;
                for (int u = blockIdx.x; u < 512; u += G) { mixerA1_unit(u, PROJ, YC, LPA, KMAX + l * 1024, vt, wave, lane); } }
            if (EN_D) { LAUNDER(); LAS char* vt = (LAS char*)lds + wave * 16384;
                int hcur = -1; float rmax = 0.f;
                for (int u = blockIdx.x; u < 512; u += G) { const int hd = (u >> 4) & 3; if (hd != hcur) { rmax = d_stage_rpb(a.in[14] + l * 4 * 15 * 31, hd, vt, lane); hcur = hd; }
                    mixerD2_unit(u, PROJ, YC, rmax, KMAX + l * 1024, vt, wave, lane); } }
        }
        SEAM(pb + 2);
        if (IN(pb + 3) && EN_SCAN) { LAUNDER(); ssd_scan(STATES, TOT, blockIdx.x * 512 + tid, G * 512); }
        if (IN(pb + 3) && EN_A) { LAUNDER(); LAS char* vt = (LAS char*)lds + wave * 16384;
            for (int u = blockIdx.x; u < 512; u += G) { mixerA2_unit(u, PROJ, YC, LPA, KMAX + l * 1024, vt, wave, lane); } }
        SEAM(pb + 3);
        if (IN(pb + 4) && EN_S2) { LAUNDER();
            for (int u = blockIdx.x; u < 256; u += G)
                ssd_part2_unit(u, PROJ, DT, a.in[8] + l * 5 * 768, a.in[9] + l * 768, a.in[10] + l * 8, a.in[12] + l * 4, a.in[13] + l * 256, STATES, YC, lds, tid, wave, lane);
            __syncthreads();
        }
        SEAM(pb + 4);
        if (IN(pb + 5) && EN_G2) { LAUNDER();
            pg8::Gemm g{YC, WOUT + (size_t)l * 1024 * 1024, M, 1024, 1024}; pg8::StaticOrder S; S.init(M, 1024, G, (int)blockIdx.x);
            if (l == 1 && fusedp) {
                pg8::EpiOutFin E{xin, a.out, MODF + (size_t)l * 24576, a.in[16], (float*)(ws + WS_XCH2), (unsigned*)(ws + WS_BAR + 16384) + 32};
                pg8::gemm_phase<pg8::EpiOutFin, pg8::StaticOrder, true, true>(lds, g, S, E, tp);
            } else if (fusedp) {
                pg8::EpiOutMod E{xin, a.out, MODF, a.in[2] + 1024, MODF + 24576, H, (float*)(ws + WS_XCH), (unsigned*)(ws + WS_BAR + 16384)};
                pg8::gemm_phase<pg8::EpiOutMod, pg8::StaticOrder, true, true>(lds, g, S, E, tp);
            } else {
                pg8::EpiOut E{xin, a.out, MODF + (size_t)l * 24576};
                pg8::gemm_phase<pg8::EpiOut, pg8::StaticOrder, true, true>(lds, g, S, E, tp);
            }
        }
        if (!(l == 1 && fusedp)) SEAM(pb + 5);
    }
    if (IN(13) && EN_FIN && G != 256) { LAUNDER(); phase_final(a.out, a.in[16], tid, G); }
#undef IN
#undef SEAM
}

extern "C" void kernel_launch(void* const* d_in, const int* in_sizes, int n_in, void* d_out, int out_size, void* d_ws, size_t ws_size, hipStream_t stream) {
    static int grid = 0;
    if (grid == 0) {
        int dev = 0, cus = 0, per_cu = 0;
        hipGetDevice(&dev);
        hipDeviceGetAttribute(&cus, hipDeviceAttributeMultiprocessorCount, dev);
        hipFuncSetAttribute((const void*)fwd_kernel, hipFuncAttributeMaxDynamicSharedMemorySize, LDS_BYTES);
        hipOccupancyMaxActiveBlocksPerMultiprocessor(&per_cu, (const void*)fwd_kernel, 512, LDS_BYTES);
        if (per_cu < 1) per_cu = 1;
        grid = cus * per_cu;
        if (ws_size < WS_END) fprintf(stderr, "kernel_launch: workspace too small: %zu < %zu\n", ws_size, (size_t)WS_END);
        (void)hipGetLastError();
    }
    Args a{};
    for (int i = 0; i < 17; ++i) a.in[i] = (const float*)d_in[i];
    a.out = (float*)d_out; a.ws = (unsigned char*)d_ws; a.ph_lo = 0; a.ph_hi = 14;
    void* args[] = {&a};
    (void)hipMemsetAsync((char*)d_ws + WS_BAR, 0, 32768, stream);
    hipError_t e = hipLaunchCooperativeKernel((const void*)fwd_kernel, dim3(grid), dim3(512), args, LDS_BYTES, stream);
    if (e != hipSuccess) fprintf(stderr, "cooperative launch failed: %s (grid %d)\n", hipGetErrorString(e), grid);
}
```

```cpp
#include <hip/hip_runtime.h>
#include <hip/hip_cooperative_groups.h>
#include <cstdio>
#include <cstdint>
namespace cg = cooperative_groups;
namespace pg8 {
#define PG8_LAS __attribute__((address_space(3)))
typedef unsigned short bf16_t;
typedef short bf16x8 __attribute__((ext_vector_type(8)));
typedef float f32x4 __attribute__((ext_vector_type(4)));
typedef unsigned u32x4 __attribute__((ext_vector_type(4)));
constexpr int BM = 256, BK = 64, HALF = 128, HTB = HALF * BK * 2  , STAGE_BYTES = 8 * HTB, NXCD = 8, WGM = 8;

__host__ __device__ __forceinline__ int lds_byte(int r, int c) { const int st = (r >> 4) * 2 + (c >> 5), rr = r & 15, cc = c & 31, ob = rr * 64 + cc * 2; return st * 1024 + (ob ^ (((ob >> 9) & 1) << 5)); }
__host__ __device__ __forceinline__ void stage_rc(int b, int& R, int& C) { const int st = b / 1024, sb = b % 1024, swz = sb ^ (((sb >> 9) & 1) << 5); R = (st >> 1) * 16 + swz / 64; C = (st & 1) * 32 + (swz % 64) / 2; }
__host__ __device__ __forceinline__ int perm32(int rho) { const int n = rho >> 4, i = rho & 15; return 8 * (i >> 2) + 4 * n + (i & 3); }

struct Unit { int pm, pn; };
struct Gemm { const bf16_t* A; const bf16_t* Bt; int M, N, K; };

struct StaticOrder {
    int nM, nN, nwg, G, c;
    __host__ __device__ void init(int M, int N, int G_, int c_) { nM = M / BM; nN = N / BM; nwg = nM * nN; G = G_; c = c_; }
    __host__ __device__ bool next(int i, Unit& u) const {
        const long L = (long)i * G + c; if (L >= nwg) return false;
        int wgid = (int)L; { const int q = nwg / NXCD, r = nwg % NXCD, xcd = wgid % NXCD, off = wgid / NXCD; wgid = (xcd < r ? xcd * (q + 1) : r * (q + 1) + (xcd - r) * q) + off; }
        const int nig = WGM * nN, gid = wgid / nig, fm = gid * WGM, gsz = (nM - fm) < WGM ? (nM - fm) : WGM;
        u.pm = fm + ((wgid % nig) % gsz); u.pn = (wgid % nig) / gsz; return true;
    }
    __device__ __forceinline__ void a_ready(const Unit&) const {}
    __device__ __forceinline__ void done(const Unit&) const {}
};
__device__ __forceinline__ unsigned cvt_pk_bf16(float lo, float hi) { unsigned r; asm volatile("v_cvt_pk_bf16_f32 %0, %1, %2" : "=v"(r) : "v"(lo), "v"(hi)); return r; }
typedef unsigned u32x4e __attribute__((ext_vector_type(4)));
struct EpiProj {
    static constexpr bool PERM = true, AFTER_DRAIN = false;
    bf16_t* O; unsigned* kmax; PG8_LAS unsigned char* epl;
    __device__ __forceinline__ void operator()(const f32x4 (&acc)[2][2][4][2], const Unit& u, int wr, int wc, int fr, int fq) const {
        const int row0 = u.pm * BM + wr * 64 + fr; const int col0 = u.pn * BM + wc * 32 + 8 * fq;
#pragma unroll
        for (int ai = 0; ai < 2; ++ai)
#pragma unroll
            for (int m = 0; m < 4; ++m) {
#pragma unroll
                for (int bj = 0; bj < 2; ++bj) { const f32x4 v0 = acc[ai][bj][m][0], v1 = acc[ai][bj][m][1];
                    u32x4 w; w.x = cvt_pk_bf16(v0[0], v0[1]); w.y = cvt_pk_bf16(v0[2], v0[3]); w.z = cvt_pk_bf16(v1[0], v1[1]); w.w = cvt_pk_bf16(v1[2], v1[3]);
                    PG8_LAS unsigned char* tl = epl + (wr * 4 + wc) * 2048 + ((ai * 4 + m) * 2 + bj) % 2 * 1024;
                    const int ln = fq * 16 + fr;
                    *(PG8_LAS u32x4*)(tl + fr * 64 + ((fq ^ (fr >> 2)) & 3) * 16) = w;
                    const int r2 = ln >> 2, p2 = ln & 3;
                    const u32x4 w2 = *(const PG8_LAS u32x4*)(tl + r2 * 64 + ((p2 ^ (r2 >> 2)) & 3) * 16);
                    const int cc = u.pn * BM + bj * HALF + wc * 32;
                    bf16_t* dst = O + ((size_t)(cc >> 6) * 16384 + (size_t)(u.pm * BM + wr * 64 + ai * HALF + m * 16 + r2)) * 64 + (cc & 63) + p2 * 8;
                    *(u32x4*)dst = w2; } }
        if (u.pn == 1 || u.pn == 5 || u.pn == 13) {
            float mx[2] = {0.f, 0.f};
#pragma unroll
            for (int ai = 0; ai < 2; ++ai)
#pragma unroll
                for (int m = 0; m < 4; ++m)
#pragma unroll
                    for (int bj = 0; bj < 2; ++bj) { const f32x4 v0 = acc[ai][bj][m][0], v1 = acc[ai][bj][m][1];
                        float ss = (v0[0] * v0[0] + v0[1] * v0[1]) + (v0[2] * v0[2] + v0[3] * v0[3]) + (v1[0] * v1[0] + v1[1] * v1[1]) + (v1[2] * v1[2] + v1[3] * v1[3]);
                        ss += __shfl_xor(ss, 16); ss += __shfl_xor(ss, 32); mx[bj] = fmaxf(mx[bj], ss); }
#pragma unroll
            for (int bj = 0; bj < 2; ++bj) {
#pragma unroll
                for (int o = 1; o < 16; o <<= 1) mx[bj] = fmaxf(mx[bj], __shfl_xor(mx[bj], o));
                if (fr == 0 && fq == 0) __hip_atomic_fetch_max(kmax + ((u.pm * BM) >> 11) * 128 + u.pn * 8 + bj * 4 + wc, __builtin_bit_cast(unsigned, mx[bj]), __ATOMIC_RELAXED, __HIP_MEMORY_SCOPE_AGENT); }
        }
    }
};
struct EpiOut {
    static constexpr bool PERM = false, AFTER_DRAIN = false;
    const float* xin; float* xout; const float* modf;
    __device__ __forceinline__ void operator()(const f32x4 (&acc)[2][2][4][2], const Unit& u, int wr, int wc, int fr, int fq) const {
        const int row0 = u.pm * BM + wr * 64 + fr; const int col0 = u.pn * BM + wc * 32 + 4 * fq;
        const int b = (u.pm * BM) >> 11;
        f32x4 gt[2][2];
#pragma unroll
        for (int bj = 0; bj < 2; ++bj)
#pragma unroll
            for (int n = 0; n < 2; ++n) gt[bj][n] = *(const f32x4*)(modf + (size_t)b * 3072 + 2048 + col0 + bj * HALF + 16 * n);
#pragma unroll
        for (int ai = 0; ai < 2; ++ai)
#pragma unroll
            for (int m = 0; m < 4; ++m) { const size_t ro = (size_t)(row0 + ai * HALF + m * 16) * 1024 + col0;
#pragma unroll
                for (int bj = 0; bj < 2; ++bj)
#pragma unroll
                    for (int n = 0; n < 2; ++n) { const size_t o = ro + bj * HALF + 16 * n; const f32x4 xi = *(const f32x4*)(xin + o);
                        *(f32x4*)(xout + o) = xi + gt[bj][n] * acc[ai][bj][m][n]; } }
    }
};
struct EpiOutFin {
    static constexpr bool PERM = false, AFTER_DRAIN = true;
    const float* xin; float* xout; const float* modf; const float* fw; float* xch; unsigned* cnt;
    __device__ __forceinline__ void operator()(const f32x4 (&acc)[2][2][4][2], const Unit& u, int wr, int wc, int fr, int fq) const {}
    __device__ __forceinline__ void fused(f32x4 (&acc)[2][2][4][2], const Unit& u, int wr, int wc, int fr, int fq, PG8_LAS unsigned char* lds, int wid, int lane) const {
        const int row0 = u.pm * BM + wr * 64 + fr; const int col0 = u.pn * BM + wc * 32 + 4 * fq;
        const int b = (u.pm * BM) >> 11;
        PG8_LAS float* P = (PG8_LAS float*)lds; PG8_LAS float* S = P + 1024;
        f32x4 gt[2][2];
#pragma unroll
        for (int bj = 0; bj < 2; ++bj)
#pragma unroll
            for (int n = 0; n < 2; ++n) gt[bj][n] = *(const f32x4*)(modf + (size_t)b * 3072 + 2048 + col0 + bj * HALF + 16 * n);
#pragma unroll
        for (int ai = 0; ai < 2; ++ai)
#pragma unroll
            for (int m = 0; m < 4; ++m) { const size_t ro = (size_t)(row0 + ai * HALF + m * 16) * 1024 + col0; float s = 0.f;
#pragma unroll
                for (int bj = 0; bj < 2; ++bj)
#pragma unroll
                    for (int n = 0; n < 2; ++n) { const f32x4 xi = __builtin_nontemporal_load((const f32x4*)(xin + ro + bj * HALF + 16 * n));
                        const f32x4 v = xi + gt[bj][n] * acc[ai][bj][m][n]; acc[ai][bj][m][n] = v;
                        s += (v[0] * v[0] + v[1] * v[1]) + (v[2] * v[2] + v[3] * v[3]); }
                s += __shfl_xor(s, 16); s += __shfl_xor(s, 32);
                if (fq == 0) P[(ai * HALF + wr * 64 + m * 16 + fr) * 4 + wc] = s; }
        __syncthreads();
        const int t = wid * 64 + lane;
        if (t < 256) { const float rs = (P[t * 4] + P[t * 4 + 1]) + (P[t * 4 + 2] + P[t * 4 + 3]);
            __hip_atomic_store(xch + ((size_t)u.pm * 256 + t) * 4 + u.pn, rs, __ATOMIC_RELAXED, __HIP_MEMORY_SCOPE_AGENT); }
        asm volatile("s_waitcnt vmcnt(0)" ::: "memory");
        __syncthreads();
        if (t == 0) {
            __hip_atomic_fetch_add(cnt + 64 * u.pm, 1u, __ATOMIC_RELAXED, __HIP_MEMORY_SCOPE_AGENT);
            unsigned sp = 0;
            while (__hip_atomic_load(cnt + 64 * u.pm, __ATOMIC_RELAXED, __HIP_MEMORY_SCOPE_AGENT) < 4u) { __builtin_amdgcn_s_sleep(1); if (++sp > (1u << 22)) break; }
        }
        __syncthreads();
        if (t < 256) { float tot = 0.f;
#pragma unroll
            for (int pn2 = 0; pn2 < 4; ++pn2) tot += __hip_atomic_load(xch + ((size_t)u.pm * 256 + t) * 4 + pn2, __ATOMIC_RELAXED, __HIP_MEMORY_SCOPE_AGENT);
            S[t] = rsqrtf(tot * (1.f / 1024.f) + 1e-6f); }
        __syncthreads();
        f32x4 fwv[2][2];
#pragma unroll
        for (int bj = 0; bj < 2; ++bj)
#pragma unroll
            for (int n = 0; n < 2; ++n) fwv[bj][n] = *(const f32x4*)(fw + col0 + bj * HALF + 16 * n);
#pragma unroll
        for (int ai = 0; ai < 2; ++ai)
#pragma unroll
            for (int m = 0; m < 4; ++m) { const float rstd = S[ai * HALF + wr * 64 + m * 16 + fr]; const size_t ro = (size_t)(row0 + ai * HALF + m * 16) * 1024 + col0;
#pragma unroll
                for (int bj = 0; bj < 2; ++bj)
#pragma unroll
                    for (int n = 0; n < 2; ++n) *(f32x4*)(xout + ro + bj * HALF + 16 * n) = acc[ai][bj][m][n] * rstd * fwv[bj][n]; }
        __syncthreads();
    }
};
struct EpiOutMod {
    static constexpr bool PERM = false, AFTER_DRAIN = true;
    const float* xin; float* xout; const float* modf; const float* nw; const float* modf2; bf16_t* Hn; float* xch; unsigned* cnt;
    __device__ __forceinline__ void operator()(const f32x4 (&acc)[2][2][4][2], const Unit& u, int wr, int wc, int fr, int fq) const {}
    __device__ __forceinline__ void fused(f32x4 (&acc)[2][2][4][2], const Unit& u, int wr, int wc, int fr, int fq, PG8_LAS unsigned char* lds, int wid, int lane) const {
        const int row0 = u.pm * BM + wr * 64 + fr; const int col0 = u.pn * BM + wc * 32 + 4 * fq;
        const int b = (u.pm * BM) >> 11;
        PG8_LAS float* P = (PG8_LAS float*)lds; PG8_LAS float* S = P + 1024;
        {
        f32x4 gt[2][2];
#pragma unroll
        for (int bj = 0; bj < 2; ++bj)
#pragma unroll
            for (int n = 0; n < 2; ++n) gt[bj][n] = *(const f32x4*)(modf + (size_t)b * 3072 + 2048 + col0 + bj * HALF + 16 * n);
#pragma unroll
        for (int ai = 0; ai < 2; ++ai)
#pragma unroll
            for (int m = 0; m < 4; ++m) { const size_t ro = (size_t)(row0 + ai * HALF + m * 16) * 1024 + col0; float s = 0.f;
#pragma unroll
                for (int bj = 0; bj < 2; ++bj)
#pragma unroll
                    for (int n = 0; n < 2; ++n) { const f32x4 xi = __builtin_nontemporal_load((const f32x4*)(xin + ro + bj * HALF + 16 * n));
                        const f32x4 v = xi + gt[bj][n] * acc[ai][bj][m][n]; acc[ai][bj][m][n] = v;
                        *(f32x4*)(xout + ro + bj * HALF + 16 * n) = v;
                        s += (v[0] * v[0] + v[1] * v[1]) + (v[2] * v[2] + v[3] * v[3]); }
                s += __shfl_xor(s, 16); s += __shfl_xor(s, 32);
                if (fq == 0) P[(ai * HALF + wr * 64 + m * 16 + fr) * 4 + wc] = s; }
        }
        __syncthreads();
        const int t = wid * 64 + lane;
        if (t < 256) { const float rs = (P[t * 4] + P[t * 4 + 1]) + (P[t * 4 + 2] + P[t * 4 + 3]);
            __hip_atomic_store(xch + ((size_t)u.pm * 256 + t) * 4 + u.pn, rs, __ATOMIC_RELAXED, __HIP_MEMORY_SCOPE_AGENT); }
        asm volatile("s_waitcnt vmcnt(0)" ::: "memory");
        __syncthreads();
        if (t == 0) {
            __hip_atomic_fetch_add(cnt + 64 * u.pm, 1u, __ATOMIC_RELAXED, __HIP_MEMORY_SCOPE_AGENT);
            unsigned sp = 0;
            while (__hip_atomic_load(cnt + 64 * u.pm, __ATOMIC_RELAXED, __HIP_MEMORY_SCOPE_AGENT) < 4u) { __builtin_amdgcn_s_sleep(1); if (++sp > (1u << 22)) break; }
        }
        f32x4 mul[2][2], add[2][2];
#pragma unroll
        for (int bj = 0; bj < 2; ++bj)
#pragma unroll
            for (int n = 0; n < 2; ++n) { const int c = col0 + bj * HALF + 16 * n;
                mul[bj][n] = *(const f32x4*)(nw + c) * (*(const f32x4*)(modf2 + (size_t)b * 3072 + 1024 + c) + 1.f); add[bj][n] = *(const f32x4*)(modf2 + (size_t)b * 3072 + c); }
        __syncthreads();
        if (t < 256) { float tot = 0.f;
#pragma unroll
            for (int pn2 = 0; pn2 < 4; ++pn2) tot += __hip_atomic_load(xch + ((size_t)u.pm * 256 + t) * 4 + pn2, __ATOMIC_RELAXED, __HIP_MEMORY_SCOPE_AGENT);
            S[t] = rsqrtf(tot * (1.f / 1024.f) + 1e-6f); }
        __syncthreads();
#pragma unroll
        for (int ai = 0; ai < 2; ++ai)
#pragma unroll
            for (int m = 0; m < 4; ++m) { const float rstd = S[ai * HALF + wr * 64 + m * 16 + fr]; bf16_t* hp = Hn + (size_t)(row0 + ai * HALF + m * 16) * 1024 + col0;
#pragma unroll
                for (int bj = 0; bj < 2; ++bj) { const f32x4 h0 = acc[ai][bj][m][0] * rstd * mul[bj][0] + add[bj][0], h1 = acc[ai][bj][m][1] * rstd * mul[bj][1] + add[bj][1];
                    typedef unsigned u32x2e __attribute__((ext_vector_type(2)));
                    u32x2e w0, w1; w0.x = cvt_pk_bf16(h0[0], h0[1]); w0.y = cvt_pk_bf16(h0[2], h0[3]); w1.x = cvt_pk_bf16(h1[0], h1[1]); w1.y = cvt_pk_bf16(h1[2], h1[3]);
                    *(u32x2e*)(hp + bj * HALF) = w0; *(u32x2e*)(hp + bj * HALF + 16) = w1; } }
        __syncthreads();
    }
};
template <class Epi, class Sched, bool ALIGN_EPI = false, bool SP2 = false>
__device__ __forceinline__ void gemm_phase(PG8_LAS unsigned char* lds, const Gemm g, const Sched& S, const Epi& E, const int tid) {
    const int wid = __builtin_amdgcn_readfirstlane(tid >> 6), lane = tid & 63, wr = wid >> 2, wc = wid & 3, fr = lane & 15, fq = lane >> 4;
    const int K = g.K, nt = K / BK;
    unsigned voffA[2], voffB[2];
#pragma unroll
    for (int i = 0; i < 2; ++i) { int R, C; stage_rc(tid * 16 + i * 8192, R, C); const int Rb = Epi::PERM ? ((R & ~31) + perm32(R & 31)) : R;
        voffA[i] = (unsigned)(R * K + C) * 2u; voffB[i] = (unsigned)(Rb * K + C) * 2u; }
    const size_t kstep = (size_t)(BK * 2);
    const size_t hstep = (size_t)HALF * K * 2;
    const size_t tstep = 2 * hstep;
    const unsigned ldsw = (unsigned)wid * 1024u;
    const int aoff = lds_byte(wr * 64 + fr, fq * 8), boff = lds_byte(wc * 32 + fr, fq * 8);
#define PG8_SA(b, h) (((b) * 2 + (h)) * HTB)
#define PG8_SB(b, h) ((4 + (b) * 2 + (h)) * HTB)
#define PG8_STAGE(bufoff, gbase, voff) do { _Pragma("unroll") for (int _i = 0; _i < 2; ++_i) \
        __builtin_amdgcn_global_load_lds((const unsigned*)((const char*)(gbase) + (voff)[_i]), (PG8_LAS unsigned*)(lds + (bufoff) + ldsw + _i * 8192), 16, 0, 0); } while (0)
#define PG8_LDA(dst, b, h) do { _Pragma("unroll") for (int m = 0; m < 4; ++m) _Pragma("unroll") for (int k = 0; k < 2; ++k) dst[m][k] = *(const PG8_LAS bf16x8*)(lds + PG8_SA(b, h) + aoff + m * 2048 + k * 1024); } while (0)
#define PG8_LDB(dst, b, h) do { _Pragma("unroll") for (int n = 0; n < 2; ++n) _Pragma("unroll") for (int k = 0; k < 2; ++k) dst[n][k] = *(const PG8_LAS bf16x8*)(lds + PG8_SB(b, h) + boff + n * 2048 + k * 1024); } while (0)
#define PG8_MMA(ai, bj, At, Bt) do { __builtin_amdgcn_s_setprio(1); _Pragma("unroll") for (int m = 0; m < 4; ++m) _Pragma("unroll") for (int n = 0; n < 2; ++n) _Pragma("unroll") for (int k = 0; k < 2; ++k) \
        acc[ai][bj][m][n] = __builtin_amdgcn_mfma_f32_16x16x32_bf16(Bt[n][k], At[m][k], acc[ai][bj][m][n], 0, 0, 0); __builtin_amdgcn_s_setprio(0); } while (0)
#define PG8_WAIT_V(n) asm volatile("s_waitcnt vmcnt(" #n ")" ::: "memory")
#define PG8_WAIT_L(n) asm volatile("s_waitcnt lgkmcnt(" #n ")" ::: "memory")
#define PG8_BAR __builtin_amdgcn_s_barrier()
#define PG8_SCHED __builtin_amdgcn_sched_barrier(0)
    Unit cur, nxt; int ui = 0;
    if (!S.next(0, cur)) return;
    f32x4 acc[2][2][4][2];
#pragma unroll
    for (int a = 0; a < 2; ++a)
#pragma unroll
        for (int b = 0; b < 2; ++b)
#pragma unroll
            for (int m = 0; m < 4; ++m)
#pragma unroll
                for (int n = 0; n < 2; ++n) acc[a][b][m][n] = (f32x4){0.f, 0.f, 0.f, 0.f};
    bf16x8 At[4][2], B0[2][2], B1[2][2];
    const char* cA = (const char*)g.A + (size_t)cur.pm * tstep; const char* cB = (const char*)g.Bt + (size_t)cur.pn * tstep;
    S.a_ready(cur);
    if constexpr (SP2) {
        PG8_STAGE(PG8_SB(0, 0), cB, voffB); PG8_STAGE(PG8_SB(0, 1), cB + hstep, voffB); PG8_STAGE(PG8_SA(0, 0), cA, voffA); PG8_STAGE(PG8_SA(0, 1), cA + hstep, voffA);
        if (wr == 1) PG8_BAR;
        PG8_WAIT_V(2); PG8_BAR;
        PG8_STAGE(PG8_SB(1, 0), cB + kstep, voffB); PG8_STAGE(PG8_SA(1, 0), cA + kstep, voffA); PG8_STAGE(PG8_SB(1, 1), cB + hstep + kstep, voffB);
        PG8_WAIT_V(6); PG8_BAR;
    } else {
        PG8_STAGE(PG8_SB(0, 0), cB, voffB); PG8_STAGE(PG8_SA(0, 0), cA, voffA); PG8_STAGE(PG8_SB(0, 1), cB + hstep, voffB); PG8_STAGE(PG8_SA(0, 1), cA + hstep, voffA);
        if (wr == 1) PG8_BAR;
        PG8_WAIT_V(4); PG8_BAR;
        PG8_STAGE(PG8_SB(1, 0), cB + kstep, voffB); PG8_STAGE(PG8_SA(1, 0), cA + kstep, voffA); PG8_STAGE(PG8_SB(1, 1), cB + hstep + kstep, voffB);
        PG8_WAIT_V(6); PG8_BAR;
    }
    for (;;) {
        const bool has_next = S.next(ui + 1, nxt);
        const char* nA = has_next ? (const char*)g.A + (size_t)nxt.pm * tstep : cA; const char* nB = has_next ? (const char*)g.Bt + (size_t)nxt.pn * tstep : cB;
        for (int t = 0; t < nt; t += 2) {
            const bool last = (t == nt - 2);
            const char* a1 = cA + (size_t)(t + 1) * kstep;
            const char* a2 = last ? nA : cA + (size_t)(t + 2) * kstep; const char* b2 = last ? nB : cB + (size_t)(t + 2) * kstep;
            const char* a3 = a2 + kstep; const char* b3 = b2 + kstep;
            if (last && has_next) S.a_ready(nxt);
            if constexpr (SP2) {
            PG8_LDB(B0, 0, 0); PG8_LDB(B1, 0, 1); PG8_SCHED; PG8_LDA(At, 0, 0); PG8_STAGE(PG8_SA(1, 1), a1 + hstep, voffA);
            PG8_WAIT_V(8); PG8_WAIT_L(0); PG8_BAR; PG8_MMA(0, 0, At, B0); PG8_MMA(0, 1, At, B1); PG8_BAR; PG8_SCHED;
            PG8_LDA(At, 0, 1); PG8_STAGE(PG8_SB(0, 0), b2, voffB); PG8_STAGE(PG8_SB(0, 1), b2 + hstep, voffB); PG8_STAGE(PG8_SA(0, 0), a2, voffA);
            PG8_WAIT_V(8); PG8_WAIT_L(0); PG8_BAR; PG8_MMA(1, 0, At, B0); PG8_MMA(1, 1, At, B1); PG8_BAR; PG8_SCHED;
            PG8_LDB(B0, 1, 0); PG8_LDB(B1, 1, 1); PG8_SCHED; PG8_LDA(At, 1, 0); PG8_STAGE(PG8_SA(0, 1), a2 + hstep, voffA);
            PG8_WAIT_V(8); PG8_WAIT_L(0); PG8_BAR; PG8_MMA(0, 0, At, B0); PG8_MMA(0, 1, At, B1); PG8_BAR; PG8_SCHED;
            PG8_LDA(At, 1, 1); PG8_STAGE(PG8_SB(1, 0), b3, voffB); PG8_STAGE(PG8_SB(1, 1), b3 + hstep, voffB); PG8_STAGE(PG8_SA(1, 0), a3, voffA);
            PG8_WAIT_V(8); PG8_WAIT_L(0); PG8_BAR; PG8_MMA(1, 0, At, B0); PG8_MMA(1, 1, At, B1); PG8_BAR; PG8_SCHED;
            } else {
            PG8_LDB(B0, 0, 0); PG8_SCHED; PG8_LDA(At, 0, 0); PG8_STAGE(PG8_SA(1, 1), a1 + hstep, voffA);
            PG8_WAIT_L(8); PG8_BAR; PG8_WAIT_L(0); PG8_MMA(0, 0, At, B0); PG8_BAR; PG8_SCHED;
            PG8_LDB(B1, 0, 1); PG8_STAGE(PG8_SB(0, 0), b2, voffB);
            PG8_BAR; PG8_WAIT_L(0); PG8_MMA(0, 1, At, B1); PG8_BAR;
            PG8_LDA(At, 0, 1); PG8_STAGE(PG8_SA(0, 0), a2, voffA);
            PG8_BAR; PG8_WAIT_L(0); PG8_MMA(1, 0, At, B0); PG8_BAR; PG8_SCHED;
            PG8_STAGE(PG8_SB(0, 1), b2 + hstep, voffB);
            PG8_WAIT_V(6); PG8_BAR; PG8_MMA(1, 1, At, B1); PG8_BAR;
            PG8_LDB(B0, 1, 0); PG8_SCHED; PG8_LDA(At, 1, 0); PG8_STAGE(PG8_SA(0, 1), a2 + hstep, voffA);
            PG8_WAIT_L(8); PG8_BAR; PG8_WAIT_L(0); PG8_MMA(0, 0, At, B0); PG8_BAR; PG8_SCHED;
            PG8_LDB(B1, 1, 1); PG8_STAGE(PG8_SB(1, 0), b3, voffB);
            PG8_BAR; PG8_WAIT_L(0); PG8_MMA(0, 1, At, B1); PG8_BAR;
            PG8_LDA(At, 1, 1); PG8_STAGE(PG8_SA(1, 0), a3, voffA);
            PG8_BAR; PG8_WAIT_L(0); PG8_MMA(1, 0, At, B0); PG8_BAR; PG8_SCHED;
            PG8_STAGE(PG8_SB(1, 1), b3 + hstep, voffB);
            PG8_WAIT_V(6); PG8_BAR; PG8_MMA(1, 1, At, B1); PG8_BAR;
            }
        }
        if constexpr (ALIGN_EPI) { if (wr == 0) PG8_BAR; }
        if constexpr (!Epi::AFTER_DRAIN) { E(acc, cur, wr, wc, fr, fq); S.done(cur); }
        if (!has_next) break;
#pragma unroll
        for (int a = 0; a < 2; ++a)
#pragma unroll
            for (int b = 0; b < 2; ++b)
#pragma unroll
                for (int m = 0; m < 4; ++m)
#pragma unroll
                    for (int n = 0; n < 2; ++n) acc[a][b][m][n] = (f32x4){0.f, 0.f, 0.f, 0.f};
        cur = nxt; cA = nA; cB = nB; ++ui;
        if constexpr (ALIGN_EPI) { if (wr == 1) PG8_BAR; }
    }
    PG8_WAIT_V(0);
    if constexpr (!ALIGN_EPI) { if (wr == 0) PG8_BAR; }
    PG8_BAR;
    if constexpr (Epi::AFTER_DRAIN) { E.fused(acc, cur, wr, wc, fr, fq, lds, wid, lane); S.done(cur); }
#undef PG8_SA
#undef PG8_SB
#undef PG8_STAGE
#undef PG8_LDA
#undef PG8_LDB
#undef PG8_MMA
#undef PG8_WAIT_V
#undef PG8_WAIT_L
#undef PG8_BAR
#undef PG8_SCHED
}
}
#define DI __device__ __forceinline__
#define LAS __attribute__((address_space(3)))
typedef unsigned short bf16;
typedef float f32x4 __attribute__((ext_vector_type(4)));
typedef float f32x2_t __attribute__((ext_vector_type(2)));
typedef __bf16 bf16x2_t __attribute__((ext_vector_type(2)));
typedef short bf16x8 __attribute__((ext_vector_type(8)));
typedef short s16x4 __attribute__((ext_vector_type(4)));
typedef unsigned u32x4 __attribute__((ext_vector_type(4)));
typedef unsigned u32x2 __attribute__((ext_vector_type(2)));
#define MFMA16(a, b, c) __builtin_amdgcn_mfma_f32_16x16x32_bf16((a), (b), (c), 0, 0, 0)

constexpr int NB = 8, T = 2048, D = 1024, M = NB * T, DIN = 4104, NP = 4096;
constexpr float EPS = 1e-6f, LOG2E = 1.4426950408889634f;
constexpr int C_AQ = 0, C_AK = 256, C_AV = 512, C_AG = 768, C_BQ = 1024, C_BK = 1280, C_BV = 1536, C_BG = 1792,
              C_CZ = 2048, C_CX = 2304, C_DQ = 3072, C_DK = 3328, C_DV = 3584, C_DG = 3840;
constexpr size_t MiB = (size_t)1 << 20;
constexpr size_t WS_WIN = 0, WS_WOUT = 16 * MiB, WS_MODP = 20 * MiB, WS_DT = 22 * MiB, WS_TOT = 23 * MiB, WS_KMAX = 23 * MiB + 256 * 1024, WS_WDT = 23 * MiB + 320 * 1024, WS_XCH = 23 * MiB + 640 * 1024, WS_MODF = 21 * MiB + 512 * 1024, WS_XCH2 = 22 * MiB + 512 * 1024, WS_LPA = 22 * MiB + 768 * 1024, WS_BAR = 23 * MiB + 512 * 1024, WS_H = 24 * MiB,
                 WS_PROJ = 56 * MiB, WS_ST = 184 * MiB, WS_YC = 216 * MiB, WS_END = 248 * MiB;
constexpr int LDS_BYTES = 131072 + 1024 + 16384;
constexpr int IMG_PITCH = 272, IMG_BYTES = 128 * IMG_PITCH;
constexpr int VT_PITCH = 144;

DI unsigned pk2(float lo, float hi) { f32x2_t v = {lo, hi}; bf16x2_t b = __builtin_convertvector(v, bf16x2_t); return __builtin_bit_cast(unsigned, b); }
DI float bflo(unsigned u) { return __builtin_bit_cast(float, u << 16); }
DI float bfhi(unsigned u) { return __builtin_bit_cast(float, u & 0xffff0000u); }
DI float wave_sum(float v) {
#pragma unroll
    for (int o = 1; o < 64; o <<= 1) v += __shfl_xor(v, o);
    return v;
}
DI float silu_f(float x) { return x * __builtin_amdgcn_rcpf(1.f + __expf(-x)); }
DI float ex2(float x) { return __builtin_amdgcn_exp2f(x); }
DI s16x4 vtr(const LAS char* p) { return __builtin_bit_cast(s16x4, __builtin_amdgcn_ds_read_tr16_b64_v4i16((LAS s16x4*)p)); }
DI bf16x8 cat8(s16x4 lo, s16x4 hi) { return __builtin_shufflevector(lo, hi, 0, 1, 2, 3, 4, 5, 6, 7); }
DI bf16x8 pack8(f32x4 a, f32x4 b) { u32x4 w; w.x = pk2(a[0], a[1]); w.y = pk2(a[2], a[3]); w.z = pk2(b[0], b[1]); w.w = pk2(b[2], b[3]); return __builtin_bit_cast(bf16x8, w); }
#define LDS_WAIT() asm volatile("s_waitcnt lgkmcnt(0)" ::: "memory")

DI void p0_transpose_item(const float* W, int ldw, int srccol, float scale, bf16* WT, int k0, LAS float* scr, int lane) {
    f32x4 wv[8];
#pragma unroll
    for (int i = 0; i < 8; ++i) wv[i] = __builtin_nontemporal_load((const f32x4*)(W + (size_t)(k0 + 8 * i + (lane >> 3)) * ldw + srccol + 4 * (lane & 7)));
#pragma unroll
    for (int i = 0; i < 8; ++i) { LAS float* d = scr + (8 * i + (lane >> 3)) * 33 + 4 * (lane & 7);
        d[0] = wv[i][0] * scale; d[1] = wv[i][1] * scale; d[2] = wv[i][2] * scale; d[3] = wv[i][3] * scale; }
    LDS_WAIT();
    const int c = lane & 7;
#pragma unroll
    for (int j = 0; j < 4; ++j) { const int n = (lane >> 3) + 8 * j; const LAS float* s = scr + (8 * c) * 33 + n;
        u32x4 o; o.x = pk2(s[0 * 33], s[1 * 33]); o.y = pk2(s[2 * 33], s[3 * 33]); o.z = pk2(s[4 * 33], s[5 * 33]); o.w = pk2(s[6 * 33], s[7 * 33]);
        *(u32x4*)(WT + (size_t)n * 1024 + k0 + 8 * c) = o; }
    LDS_WAIT();
}
DI void phase0(const float* cvec, const float* ada_w, const float* w_in, const float* w_out, bf16* WIN, bf16* WOUT, float* MODP, float* KMAX, bf16* WDT,
               LAS unsigned char* lds, int tid, int G) {
    const int lane = tid & 63, wave = tid >> 6;
    if (blockIdx.x == 0) for (int i = tid; i < 2 * 8 * 128; i += 512) KMAX[i] = 0.f;
    for (int i = blockIdx.x * 512 + tid; i < 32768; i += G * 512) { const int l = i >> 14, jj = (i >> 10) & 15, col = i & 1023;
        WDT[i] = jj < 8 ? (bf16)(pk2(w_in[((size_t)l * 1024 + col) * DIN + 3072 + jj], 0.f) & 0xffffu) : (bf16)0; }
    LAS float* scr = (LAS float*)(lds + wave * 16384);
    const int gw = blockIdx.x * 8 + wave, NGW = G * 8;
    constexpr int I_IN = 16 * 128, I_OUT = 16 * 32, I_L = I_IN + I_OUT;
    for (int it = gw; it < 2 * I_L; it += NGW) {
        const int l = it / I_L; int r = it - l * I_L;
        if (r < I_IN) {
            const int kb = r >> 7, nb = r & 127, n0 = 32 * nb; const int src = n0 + (n0 >= 3072 ? 8 : 0);
            float sc = 1.f;
            if (n0 < 256) sc = 0.125f * LOG2E; else if (n0 >= 1024 && n0 < 1280) sc = 0.17677669529663687f * LOG2E; else if (n0 >= 3072 && n0 < 3328) sc = 0.125f * LOG2E;
            p0_transpose_item(w_in + (size_t)l * 1024 * DIN, DIN, src, sc, WIN + ((size_t)l * NP + n0) * 1024, 64 * kb, scr, lane);
        } else {
            r -= I_IN; const int kb = r >> 5, nb = r & 31, n0 = 32 * nb;
            p0_transpose_item(w_out + (size_t)l * 1024 * 1024, 1024, n0, 1.f, WOUT + ((size_t)l * 1024 + n0) * 1024, 64 * kb, scr, lane);
        }
    }
    __syncthreads();
    for (int task = blockIdx.x; task < 192; task += G) {
        const int l = task / 96, rem = task % 96, cgp = rem >> 3, ks = rem & 7;
        const float* W = ada_w + (size_t)l * 1024 * 3072;
        const int k0 = ks * 128 + wave * 16, col = cgp * 256 + lane * 4;
        f32x4 acc[8];
#pragma unroll
        for (int b = 0; b < 8; ++b) acc[b] = (f32x4){0.f, 0.f, 0.f, 0.f};
#pragma unroll 4
        for (int kk = 0; kk < 16; ++kk) { const int k = k0 + kk; const f32x4 w = __builtin_nontemporal_load((const f32x4*)(W + (size_t)k * 3072 + col));
#pragma unroll
            for (int b = 0; b < 8; ++b) { const float ca = silu_f(cvec[b * 1024 + k]); acc[b] += w * ca; } }
        LAS float* red = (LAS float*)lds;
#pragma unroll
        for (int b = 0; b < 8; ++b) *(LAS f32x4*)(red + (wave * 8 + b) * 256 + lane * 4) = acc[b];
        __syncthreads();
        { const int idx = tid * 4, b = idx >> 8, cc = idx & 255; f32x4 s = (f32x4){0.f, 0.f, 0.f, 0.f};
#pragma unroll
          for (int w = 0; w < 8; ++w) s += *(const LAS f32x4*)(red + (w * 8 + b) * 256 + cc);
          *(f32x4*)(MODP + ((size_t)(l * 8 + ks) * 8 + b) * 3072 + cgp * 256 + cc) = s; }
        __syncthreads();
    }
}

DI void phase_modulate(const float* xin, const float* norm_w, const float* modp, const float* adab,
                       bf16* H, LAS unsigned char* lds, int tid, int G, float* MODF, const float* MODP_all, const float* adab_all) {
    const int lane = tid & 63, wave = tid >> 6;
    if (MODF) for (int idx = blockIdx.x * 512 + tid; idx < 2 * 8 * 3072; idx += G * 512) { const int l2 = idx / 24576, rem = idx - l2 * 24576, b2 = rem / 3072, c2 = rem - b2 * 3072;
        float v = adab_all[l2 * 3072 + c2];
#pragma unroll
        for (int ks = 0; ks < 8; ++ks) v += MODP_all[((size_t)(l2 * 8 + ks) * 8 + b2) * 3072 + c2];
        MODF[idx] = v; }
    LAS float* sh = (LAS float*)lds; LAS float* sc = sh + 1024;
    __syncthreads();
    f32x4 nw[4];
#pragma unroll
    for (int j = 0; j < 4; ++j) nw[j] = *(const f32x4*)(norm_w + 4 * lane + 256 * j);
    int curb = -1;
    for (int rb = blockIdx.x; rb < 256; rb += G) {
        const int b = rb >> 5;
        if (b != curb) {
            __syncthreads();
            for (int i = tid; i < 2048; i += 512) { float v = adab[i];
#pragma unroll
                for (int ks = 0; ks < 8; ++ks) v += modp[(size_t)(ks * 8 + b) * 3072 + i];
                sh[i] = (i >= 1024) ? 1.f + v : v; }
            curb = b; __syncthreads();
        }
        f32x4 vbuf[3][4];
#pragma unroll
        for (int pre = 0; pre < 2; ++pre) { const f32x4* xr = (const f32x4*)(xin + (size_t)(rb * 64 + wave + 8 * pre) * 1024) + lane;
#pragma unroll
            for (int j = 0; j < 4; ++j) vbuf[pre][j] = __builtin_nontemporal_load(xr + 64 * j); }
#pragma unroll
        for (int it = 0; it < 8; ++it) {
            const int row = rb * 64 + wave + 8 * it;
            if (it + 2 < 8) { const f32x4* xr = (const f32x4*)(xin + (size_t)(row + 16) * 1024) + lane;
#pragma unroll
                for (int j = 0; j < 4; ++j) vbuf[(it + 2) % 3][j] = __builtin_nontemporal_load(xr + 64 * j); }
            f32x4 v[4]; float ss = 0.f;
#pragma unroll
            for (int j = 0; j < 4; ++j) { v[j] = vbuf[it % 3][j]; ss += (v[j][0] * v[j][0] + v[j][1] * v[j][1]) + (v[j][2] * v[j][2] + v[j][3] * v[j][3]); }
            const float rstd = rsqrtf(wave_sum(ss) * (1.f / 1024.f) + EPS);
#pragma unroll
            for (int j = 0; j < 4; ++j) { const int col = 4 * lane + 256 * j;
                const f32x4 shv = *(const LAS f32x4*)(sh + col), scv = *(const LAS f32x4*)(sc + col);
                const f32x4 hv = v[j] * rstd * nw[j] * scv + shv;
                u32x2 o; o.x = pk2(hv[0], hv[1]); o.y = pk2(hv[2], hv[3]);
                *(u32x2*)(H + (size_t)row * 1024 + col) = o; asm volatile("" ::: "memory"); }
        }
    }
    __syncthreads();
}
DI const bf16* slab(const bf16* PROJ, int col64, int b) { return PROJ + ((size_t)(col64 >> 6) * M + (size_t)b * T) * 64; }
DI void rows16_load(LAS char* t, const bf16* base, int pitch, int tok0, int tstride, int lane) {
#pragma unroll
    for (int it = 0; it < 2; ++it) { const int n = lane + 64 * it, row = n >> 3, ch = n & 7;
        *(LAS u32x4*)(t + row * VT_PITCH + ch * 16) = *(const u32x4*)(base + (size_t)(tok0 + tstride * row) * pitch + ch * 8); }
}
DI void rows16_store(const LAS char* t, bf16* base, int pitch, int tok0, int tstride, int lane) {
#pragma unroll
    for (int it = 0; it < 2; ++it) { const int n = lane + 64 * it, row = n >> 3, ch = n & 7;
        *(u32x4*)(base + (size_t)(tok0 + tstride * row) * pitch + ch * 8) = *(const LAS u32x4*)(t + row * VT_PITCH + ch * 16); }
}
constexpr int KV_PITCH = 144, KV_TILE = 128 * KV_PITCH;
DI float sumsq8(bf16x8 v) { const u32x4 u = __builtin_bit_cast(u32x4, v); float s = 0.f;
#pragma unroll
    for (int i = 0; i < 4; ++i) { const float a = bflo(u[i]), b = bfhi(u[i]); s += a * a + b * b; }
    return s; }
struct SBlk { f32x4 a[2][2], b[2][2]; };
DI float alibi_c(float dkf, float pf, float nslope2, float nbound) { float t, c;
    asm("v_add_f32_e32 %0, %1, %2" : "=v"(t) : "s"(dkf), "v"(pf));
    asm("v_fma_f32 %0, |%1|, %2, %3" : "=v"(c) : "v"(t), "s"(nslope2), "v"(nbound));
    return c; }
DI void mixerB2_unit(int u, int l, const bf16* PROJ, bf16* YC, const float* dlam_l, const float* dnw_l, const float* kmax_l, LAS char* lds, int tid, int wave, int lane) {
    const int b = u >> 5, h = (u >> 3) & 3, qb = u & 7, r = lane & 15, g = lane >> 4, q = (lane & 15) >> 2, p = lane & 3;
    const bf16* kbase = slab(PROJ, C_BK + h * 64, b); const bf16* vbase = slab(PROJ, C_BV + h * 64, b);
    const bf16* qbase = slab(PROJ, C_BQ + h * 64, b); const bf16* gbase = slab(PROJ, C_BG + h * 64, b);
    const int q0w = qb * 256 + wave * 32;
    LAS char* Kb = lds; LAS char* Vb = lds + 2 * KV_TILE;
    const float slope2 = ex2(-(float)(2 * h + 2)) * LOG2E;
    __syncthreads();
    bf16x8 q1[2], q2[2]; float bound[2];
    LAS char* qs = lds + 92160 + wave * (32 * KV_PITCH);
#pragma unroll
    for (int qt = 0; qt < 2; ++qt) { const bf16* qp = qbase + (size_t)(q0w + 16 * qt + r) * 64 + 8 * g;
        q1[qt] = *(const bf16x8*)qp; q2[qt] = *(const bf16x8*)(qp + 32);
        *(LAS bf16x8*)(qs + (16 * qt + r) * KV_PITCH + 16 * g) = q1[qt]; *(LAS bf16x8*)(qs + (16 * qt + r) * KV_PITCH + 64 + 16 * g) = q2[qt]; }
    const int lrow = tid >> 3, lch = tid & 7;
    u32x4 rk = *(const u32x4*)(kbase + (size_t)lrow * 64 + lch * 8), rv = *(const u32x4*)(vbase + (size_t)lrow * 64 + lch * 8);
    u32x4 rk2 = *(const u32x4*)(kbase + (size_t)(lrow + 64) * 64 + lch * 8), rv2 = *(const u32x4*)(vbase + (size_t)(lrow + 64) * 64 + lch * 8);
    *(LAS u32x4*)(Kb + lrow * KV_PITCH + lch * 16) = rk; *(LAS u32x4*)(Vb + lrow * KV_PITCH + lch * 16) = rv;
    *(LAS u32x4*)(Kb + (lrow + 64) * KV_PITCH + lch * 16) = rk2; *(LAS u32x4*)(Vb + (lrow + 64) * KV_PITCH + lch * 16) = rv2;
    __syncthreads();
    { const float k1 = kmax_l[b * 128 + 40 + 2 * h], k2 = kmax_l[b * 128 + 41 + 2 * h];
#pragma unroll
      for (int qt = 0; qt < 2; ++qt) { float a = sumsq8(q1[qt]), c = sumsq8(q2[qt]);
          a += __shfl_xor(a, 16); a += __shfl_xor(a, 32); c += __shfl_xor(c, 16); c += __shfl_xor(c, 32);
          bound[qt] = fmaxf(sqrtf(a * k1), sqrtf(c * k2)) * 1.01f + 0.05f; } }
    f32x4 Pf;
#pragma unroll
    for (int i = 0; i < 4; ++i) Pf[i] = (float)(4 * g + i - r);
    const float nslope2s = __builtin_bit_cast(float, __builtin_amdgcn_readfirstlane(__builtin_bit_cast(int, -slope2)));
    float nbound[2] = {-bound[0], -bound[1]};
    f32x4 o1[2][4], o2[2][4], ol1[2], ol2[2];
#pragma unroll
    for (int qt = 0; qt < 2; ++qt) { ol1[qt] = (f32x4){0.f, 0.f, 0.f, 0.f}; ol2[qt] = ol1[qt];
#pragma unroll
        for (int c = 0; c < 4; ++c) { o1[qt][c] = ol1[qt]; o2[qt][c] = ol1[qt]; } }
    const bf16x8 ones = {0x3F80, 0x3F80, 0x3F80, 0x3F80, 0x3F80, 0x3F80, 0x3F80, 0x3F80};
    for (int kt128 = 0; kt128 < 16; ++kt128) {
        {
        const LAS char* K0 = Kb + (kt128 & 1) * KV_TILE; const LAS char* V0 = Vb + (kt128 & 1) * KV_TILE;
#define B_QK(S, hf_, ks_) do { const LAS char* Kc_ = K0 + (hf_) * 64 * KV_PITCH; bf16x8 qa[2], qb2[2]; \
        _Pragma("unroll") for (int qt = 0; qt < 2; ++qt) { qa[qt] = *(const LAS bf16x8*)(qs + (16 * qt + r) * KV_PITCH + 16 * g); qb2[qt] = *(const LAS bf16x8*)(qs + (16 * qt + r) * KV_PITCH + 64 + 16 * g); } \
        _Pragma("unroll") for (int kk = 0; kk < 2; ++kk) { const int kt = 2 * (ks_) + kk; \
            const bf16x8 kf1 = *(const LAS bf16x8*)(Kc_ + (16 * kt + r) * KV_PITCH + 16 * g), kf2 = *(const LAS bf16x8*)(Kc_ + (16 * kt + r) * KV_PITCH + 64 + 16 * g); \
            _Pragma("unroll") for (int qt = 0; qt < 2; ++qt) { const float dkf = (float)(128 * kt128 + 64 * (hf_) + 16 * kt - (q0w + 16 * qt)); f32x4 C; \
                _Pragma("unroll") for (int i = 0; i < 4; ++i) C[i] = alibi_c(dkf, Pf[i], nslope2s, nbound[qt]); \
                S.a[qt][kk] = MFMA16(kf1, qa[qt], C); S.b[qt][kk] = MFMA16(kf2, qb2[qt], C); } } } while (0)
#define B_SMPV(S, hf_, ks_) do { const LAS char* Vc_ = V0 + (hf_) * 64 * KV_PITCH; bf16x8 pf1[2], pf2[2]; \
        _Pragma("unroll") for (int qt = 0; qt < 2; ++qt) { \
            _Pragma("unroll") for (int kk = 0; kk < 2; ++kk) _Pragma("unroll") for (int i = 0; i < 4; ++i) { S.a[qt][kk][i] = ex2(S.a[qt][kk][i]); S.b[qt][kk][i] = ex2(S.b[qt][kk][i]); } \
            pf1[qt] = pack8(S.a[qt][0], S.a[qt][1]); pf2[qt] = pack8(S.b[qt][0], S.b[qt][1]); \
            ol1[qt] = MFMA16(ones, pf1[qt], ol1[qt]); ol2[qt] = MFMA16(ones, pf2[qt], ol2[qt]); } \
        const LAS char* v0 = Vc_ + (32 * (ks_) + 4 * g + q) * KV_PITCH + 8 * p; \
        _Pragma("unroll") for (int c = 0; c < 4; ++c) { const bf16x8 vf = cat8(vtr(v0 + 32 * c), vtr(v0 + 16 * KV_PITCH + 32 * c)); \
            _Pragma("unroll") for (int qt = 0; qt < 2; ++qt) { o1[qt][c] = MFMA16(vf, pf1[qt], o1[qt][c]); o2[qt][c] = MFMA16(vf, pf2[qt], o2[qt][c]); } } \
        __builtin_amdgcn_sched_barrier(0); } while (0)
        SBlk SA, SB;
        B_QK(SA, 0, 0); B_QK(SB, 0, 1);
        B_SMPV(SA, 0, 0);
        if (kt128 + 1 < 16) { const size_t ro = (size_t)(128 * (kt128 + 1) + lrow) * 64 + lch * 8; rk = *(const u32x4*)(kbase + ro); rv = *(const u32x4*)(vbase + ro); }
        B_QK(SA, 1, 0);
        B_SMPV(SB, 0, 1);
        B_QK(SB, 1, 1);
        if (kt128 + 1 < 16) { LAS char* Kn = Kb + ((kt128 + 1) & 1) * KV_TILE; LAS char* Vn = Vb + ((kt128 + 1) & 1) * KV_TILE;
            *(LAS u32x4*)(Kn + lrow * KV_PITCH + lch * 16) = rk; *(LAS u32x4*)(Vn + lrow * KV_PITCH + lch * 16) = rv;
            const size_t ro = (size_t)(128 * (kt128 + 1) + 64 + lrow) * 64 + lch * 8; rk = *(const u32x4*)(kbase + ro); rv = *(const u32x4*)(vbase + ro); }
        B_SMPV(SA, 1, 0);
        B_SMPV(SB, 1, 1);
#undef B_QK
#undef B_SMPV
        }
        if (kt128 + 1 < 16) { LAS char* Kn = Kb + ((kt128 + 1) & 1) * KV_TILE; LAS char* Vn = Vb + ((kt128 + 1) & 1) * KV_TILE;
            *(LAS u32x4*)(Kn + (lrow + 64) * KV_PITCH + lch * 16) = rk; *(LAS u32x4*)(Vn + (lrow + 64) * KV_PITCH + lch * 16) = rv; }
        __syncthreads();
    }
    float pa = 0.f, pb = 0.f;
    if (lane < 32) { pa = dlam_l[lane] * dlam_l[32 + lane]; pb = dlam_l[64 + lane] * dlam_l[96 + lane]; }
    pa = wave_sum(pa); pb = wave_sum(pb);
    const float lam_init = 0.8f - 0.6f * __expf(-0.3f * (float)l);
    const float lam = __expf(pa) - __expf(pb) + lam_init;
    LAS char* sc = lds + 4 * KV_TILE + wave * (16 * VT_PITCH);
#pragma unroll
    for (int qt = 0; qt < 2; ++qt) {
        const int tok0 = q0w + 16 * qt;
        const float i1 = 1.f / ol1[qt][0], i2 = lam / ol2[qt][0];
        f32x4 o[4]; float ss = 0.f;
#pragma unroll
        for (int c = 0; c < 4; ++c) { o[c] = o1[qt][c] * i1 - o2[qt][c] * i2; ss += (o[c][0] * o[c][0] + o[c][1] * o[c][1]) + (o[c][2] * o[c][2] + o[c][3] * o[c][3]); }
        ss += __shfl_xor(ss, 16); ss += __shfl_xor(ss, 32);
        const float rstd = rsqrtf(ss * (1.f / 64.f) + EPS) * (1.f - lam_init);
        rows16_load(sc, gbase, 64, tok0, 1, lane);
        u32x2 gv[4];
#pragma unroll
        for (int c = 0; c < 4; ++c) gv[c] = *(const LAS u32x2*)(sc + r * VT_PITCH + (16 * c + 4 * g) * 2);
#pragma unroll
        for (int c = 0; c < 4; ++c) { const int dd = 16 * c + 4 * g;
            const f32x4 nw = *(const f32x4*)(dnw_l + dd);
            const f32x4 y = o[c] * rstd * nw;
            u32x2 w; w.x = pk2(y[0] * silu_f(bflo(gv[c].x)), y[1] * silu_f(bfhi(gv[c].x))); w.y = pk2(y[2] * silu_f(bflo(gv[c].y)), y[3] * silu_f(bfhi(gv[c].y)));
            *(LAS u32x2*)(sc + r * VT_PITCH + dd * 2) = w; }
        rows16_store(sc, YC + (size_t)b * T * 1024 + 256 + h * 64, 1024, tok0, 1, lane);
    }
}

constexpr int KT_OFF = 32 * VT_PITCH;
struct TileRegs { u32x4 k[4]; u32x4 v[4]; };
DI void tile_load(TileRegs& R, const bf16* kb, const bf16* vb, int tokbase, int stride, int lane) {
#pragma unroll
    for (int it = 0; it < 4; ++it) { const int n = lane + 64 * it, row = n >> 3, ch = n & 7; int tok = tokbase + stride * row; tok = min(max(tok, 0), T - 1);
        R.k[it] = *(const u32x4*)(kb + (size_t)tok * 64 + ch * 8); R.v[it] = *(const u32x4*)(vb + (size_t)tok * 64 + ch * 8); }
}
DI void tile_v_to_lds(const TileRegs& R, LAS char* vt, int lane) {
#pragma unroll
    for (int it = 0; it < 4; ++it) { const int n = lane + 64 * it, row = n >> 3, ch = n & 7;
        *(LAS u32x4*)(vt + row * VT_PITCH + ch * 16) = R.v[it]; *(LAS u32x4*)(vt + KT_OFF + row * VT_PITCH + ch * 16) = R.k[it]; }
}
DI bf16x8 k_frag_at(const LAS char* kt, int t, int ks, int lane) { return *(const LAS bf16x8*)(kt + (16 * t + (lane & 15)) * VT_PITCH + 64 * ks + 16 * (lane >> 4)); }
DI bf16x8 k_frag(const LAS char* vt, int t, int ks, int lane) { return k_frag_at(vt + KT_OFF, t, ks, lane); }
constexpr int SC_OFF = 64 * VT_PITCH;
DI void fb_update(f32x4 (&o)[4], f32x4& ol, const f32x4 st0, const f32x4 st1, const LAS char* vt, int lane) {
    f32x4 p0, p1;
#pragma unroll
    for (int i = 0; i < 4; ++i) { p0[i] = ex2(st0[i]); p1[i] = ex2(st1[i]); }
    const bf16x8 pf = pack8(p0, p1);
    const bf16x8 ones = {0x3F80, 0x3F80, 0x3F80, 0x3F80, 0x3F80, 0x3F80, 0x3F80, 0x3F80};
    ol = MFMA16(ones, pf, ol);
    const int g = lane >> 4, q = (lane & 15) >> 2, p = lane & 3;
    const LAS char* v0 = vt + (4 * g + q) * VT_PITCH + 8 * p;
    const LAS char* v1 = v0 + 16 * VT_PITCH;
#pragma unroll
    for (int c = 0; c < 4; ++c) { const bf16x8 vf = cat8(vtr(v0 + 32 * c), vtr(v1 + 32 * c)); o[c] = MFMA16(vf, pf, o[c]); }
}
DI float q_norm2(const bf16x8 (&qf)[2]) { float a = sumsq8(qf[0]) + sumsq8(qf[1]); a += __shfl_xor(a, 16); a += __shfl_xor(a, 32); return a; }

DI void a_desc(int ti, int a0, int rho, int& tokbase, int& stride, int& maxd) {
    if (ti < 4) { stride = 16; tokbase = rho + 512 * ti; maxd = 1024; }
    else if (ti < 10) { stride = 4; const int m0 = 4 * a0 + (rho >> 2) - 64 + 32 * (ti - 4); tokbase = 4 * m0 + (rho & 3); maxd = 256; }
    else { stride = 1; tokbase = 16 * a0 + rho - 64 + 32 * (ti - 10); maxd = 64; }
}
template <bool EDGE>
DI void a_scores(f32x4 (&st)[2], const LAS char* kt, const bf16x8 (&qf)[2], const f32x4 cinit, int tokbase, int stride, int maxd, int tq, float nslope2, int lane) {
    const int g = lane >> 4;
    const int base0 = tokbase + stride * 4 * g - tq;
#pragma unroll
    for (int t = 0; t < 2; ++t) {
        st[t] = MFMA16(k_frag_at(kt, t, 0, lane), qf[0], cinit); st[t] = MFMA16(k_frag_at(kt, t, 1, lane), qf[1], st[t]);
#pragma unroll
        for (int i = 0; i < 4; ++i) { const int d = base0 + stride * (16 * t + i);
            bool ok = (unsigned)(d + maxd) <= (unsigned)(2 * maxd);
            if (EDGE) ok = ok && ((unsigned)(d + tq) < (unsigned)T);
            const float v = __builtin_fmaf(__builtin_fabsf((float)d), nslope2, st[t][i]);
            st[t][i] = ok ? v : -1e30f; }
    }
}
constexpr int A_V1 = 32 * VT_PITCH, A_K = 64 * VT_PITCH;
DI void a_stage(f32x4 (&st)[2], const TileRegs& R, LAS char* vt, int vpar, const bf16x8 (&qf)[2], const f32x4 cinit, int tokbase, int stride, int maxd, int tq, float nslope2, int lane) {
#pragma unroll
    for (int it = 0; it < 4; ++it) { const int n = lane + 64 * it, row = n >> 3, ch = n & 7;
        *(LAS u32x4*)(vt + vpar * A_V1 + row * VT_PITCH + ch * 16) = R.v[it]; *(LAS u32x4*)(vt + A_K + row * VT_PITCH + ch * 16) = R.k[it]; }
    a_scores<true>(st, vt + A_K, qf, cinit, tokbase, stride, maxd, tq, nslope2, lane);
}
DI void a_compute(f32x4 (&o)[4], f32x4& ol, const TileRegs& R, const bf16x8 (&qf)[2], const f32x4 cinit, int ti, int a0, int rho, int tq, float nslope2, LAS char* vt, int lane) {
    int tokbase, stride, maxd; a_desc(ti, a0, rho, tokbase, stride, maxd);
    tile_v_to_lds(R, vt, lane);
    f32x4 st[2];
    a_scores<true>(st, vt + KT_OFF, qf, cinit, tokbase, stride, maxd, tq, nslope2, lane);
    fb_update(o, ol, st[0], st[1], vt, lane);
    asm volatile("" ::: "memory");
}
DI float a_bound(const bf16x8 (&qf)[2], const float* kmax_l, int b, int h) { return sqrtf(q_norm2(qf) * (kmax_l[b * 128 + 8 + 2 * h] + kmax_l[b * 128 + 9 + 2 * h])) * 1.01f + 0.05f; }
DI void a1_compute(f32x4 (&o)[4], f32x4& ol, const TileRegs& R, const bf16x8 (&qf)[2], const f32x4 cinit, int tokbase, int tq, float nslope2, LAS char* vt, int lane) {
    tile_v_to_lds(R, vt, lane);
    f32x4 st[2];
    a_scores<true>(st, vt + KT_OFF, qf, cinit, tokbase, 1, 64, tq, nslope2, lane);
    fb_update(o, ol, st[0], st[1], vt, lane);
    asm volatile("" ::: "memory");
}
DI void mixerA1_unit(int u, const bf16* PROJ, bf16* YC, float* LPA, const float* kmax_l, LAS char* vt, int wave, int lane) {
    const int b = u >> 6, h = (u >> 4) & 3, qblk = u & 15, r = lane & 15, g = lane >> 4;
    const bf16* kb = slab(PROJ, C_AK + h * 64, b); const bf16* vb = slab(PROJ, C_AV + h * 64, b);
    const int t0 = qblk * 128 + wave * 16, tq = t0 + r;
    bf16x8 qf[2];
#pragma unroll
    for (int ks = 0; ks < 2; ++ks) qf[ks] = *(const bf16x8*)(slab(PROJ, C_AQ + h * 64, b) + (size_t)tq * 64 + 32 * ks + 8 * g);
    const float nslope2 = -ex2(-(float)(2 * h + 1)) * LOG2E;
    const float bound = a_bound(qf, kmax_l, b, h);
    const f32x4 cinit = {-bound, -bound, -bound, -bound};
    f32x4 o[4], ol = {0.f, 0.f, 0.f, 0.f};
#pragma unroll
    for (int c = 0; c < 4; ++c) o[c] = ol;
    TileRegs R0, R1, R2;
    const int tb0 = t0 - 64;
    tile_load(R0, kb, vb, tb0, 1, lane); tile_load(R1, kb, vb, tb0 + 32, 1, lane); tile_load(R2, kb, vb, tb0 + 64, 1, lane);
    f32x4 sA[2], sB[2];
    a_stage(sA, R0, vt, 0, qf, cinit, tb0, 1, 64, tq, nslope2, lane);        tile_load(R0, kb, vb, tb0 + 96, 1, lane);
    a_stage(sB, R1, vt, 1, qf, cinit, tb0 + 32, 1, 64, tq, nslope2, lane);   tile_load(R1, kb, vb, tb0 + 128, 1, lane);
    fb_update(o, ol, sA[0], sA[1], vt, lane);
    a_stage(sA, R2, vt, 0, qf, cinit, tb0 + 64, 1, 64, tq, nslope2, lane);
    fb_update(o, ol, sB[0], sB[1], vt + A_V1, lane);
    a_stage(sB, R0, vt, 1, qf, cinit, tb0 + 96, 1, 64, tq, nslope2, lane);
    fb_update(o, ol, sA[0], sA[1], vt, lane);
    a_stage(sA, R1, vt, 0, qf, cinit, tb0 + 128, 1, 64, tq, nslope2, lane);
    fb_update(o, ol, sB[0], sB[1], vt + A_V1, lane);
    fb_update(o, ol, sA[0], sA[1], vt, lane);
    LAS char* sc = vt + SC_OFF;
#pragma unroll
    for (int c = 0; c < 4; ++c) { u32x2 w; w.x = pk2(o[c][0], o[c][1]); w.y = pk2(o[c][2], o[c][3]);
        *(LAS u32x2*)(sc + r * VT_PITCH + (16 * c + 4 * g) * 2) = w; }
    rows16_store(sc, YC + (size_t)b * T * 1024 + h * 64, 1024, t0, 1, lane);
    if (g == 0) LPA[(size_t)(b * T + tq) * 4 + h] = ol[0];
}
DI void mixerA2_unit(int u, const bf16* PROJ, bf16* YC, const float* LPA, const float* kmax_l, LAS char* vt, int wave, int lane) {
    const int b = u >> 6, h = (u >> 4) & 3, rho = u & 15, a0 = 16 * wave, r = lane & 15, g = lane >> 4;
    const bf16* kb = slab(PROJ, C_AK + h * 64, b); const bf16* vb = slab(PROJ, C_AV + h * 64, b);
    const int tq = 16 * (a0 + r) + rho;
    bf16x8 qf[2];
#pragma unroll
    for (int ks = 0; ks < 2; ++ks) qf[ks] = *(const bf16x8*)(slab(PROJ, C_AQ + h * 64, b) + (size_t)tq * 64 + 32 * ks + 8 * g);
    const float nslope2 = -ex2(-(float)(2 * h + 1)) * LOG2E;
    const float bound = a_bound(qf, kmax_l, b, h);
    const f32x4 cinit = {-bound, -bound, -bound, -bound};
    f32x4 o[4], ol = {0.f, 0.f, 0.f, 0.f};
#pragma unroll
    for (int c = 0; c < 4; ++c) o[c] = ol;
    TileRegs R0, R1, R2;
#define A_LOAD(R, t_) do { int tb_, sd_, md_; a_desc((t_), a0, rho, tb_, sd_, md_); tile_load(R, kb, vb, tb_, sd_, lane); } while (0)
    A_LOAD(R0, 0); A_LOAD(R1, 1); A_LOAD(R2, 2);
    f32x4 sA[2], sB[2];
#define A_STAGE(S, R, t_) do { int tb_, sd_, md_; a_desc((t_), a0, rho, tb_, sd_, md_); a_stage(S, R, vt, (t_) & 1, qf, cinit, tb_, sd_, md_, tq, nslope2, lane); } while (0)
    A_STAGE(sA, R0, 0); A_LOAD(R0, 3);
    A_STAGE(sB, R1, 1); A_LOAD(R1, 4);
    fb_update(o, ol, sA[0], sA[1], vt, lane);
    A_STAGE(sA, R2, 2); A_LOAD(R2, 5);
    fb_update(o, ol, sB[0], sB[1], vt + A_V1, lane);
    A_STAGE(sB, R0, 3); A_LOAD(R0, 6);
    fb_update(o, ol, sA[0], sA[1], vt, lane);
    A_STAGE(sA, R1, 4); A_LOAD(R1, 7);
    fb_update(o, ol, sB[0], sB[1], vt + A_V1, lane);
    A_STAGE(sB, R2, 5); A_LOAD(R2, 8);
    fb_update(o, ol, sA[0], sA[1], vt, lane);
    A_STAGE(sA, R0, 6); A_LOAD(R0, 9);
    fb_update(o, ol, sB[0], sB[1], vt + A_V1, lane);
    A_STAGE(sB, R1, 7);
    fb_update(o, ol, sA[0], sA[1], vt, lane);
    A_STAGE(sA, R2, 8);
    fb_update(o, ol, sB[0], sB[1], vt + A_V1, lane);
    A_STAGE(sB, R0, 9);
    fb_update(o, ol, sA[0], sA[1], vt, lane);
    fb_update(o, ol, sB[0], sB[1], vt + A_V1, lane);
#undef A_STAGE
#undef A_LOAD
    const float inv = 1.f / (ol[0] + LPA[(size_t)(b * T + tq) * 4 + h]);
    LAS char* sc = vt + SC_OFF; const int tok0 = 16 * a0 + rho;
    bf16* ybase = YC + (size_t)b * T * 1024 + h * 64;
    u32x2 pv[4], gv[4];
    rows16_load(sc, ybase, 1024, tok0, 16, lane);
#pragma unroll
    for (int c = 0; c < 4; ++c) pv[c] = *(const LAS u32x2*)(sc + r * VT_PITCH + (16 * c + 4 * g) * 2);
    rows16_load(sc, slab(PROJ, C_AG + h * 64, b), 64, tok0, 16, lane);
#pragma unroll
    for (int c = 0; c < 4; ++c) gv[c] = *(const LAS u32x2*)(sc + r * VT_PITCH + (16 * c + 4 * g) * 2);
#pragma unroll
    for (int c = 0; c < 4; ++c) {
        f32x4 ov = o[c]; ov[0] += bflo(pv[c].x); ov[1] += bfhi(pv[c].x); ov[2] += bflo(pv[c].y); ov[3] += bfhi(pv[c].y); ov = ov * inv;
        u32x2 w; w.x = pk2(ov[0] * silu_f(bflo(gv[c].x)), ov[1] * silu_f(bfhi(gv[c].x))); w.y = pk2(ov[2] * silu_f(bflo(gv[c].y)), ov[3] * silu_f(bfhi(gv[c].y)));
        *(LAS u32x2*)(sc + r * VT_PITCH + (16 * c + 4 * g) * 2) = w; }
    rows16_store(sc, ybase, 1024, tok0, 16, lane);
}
DI void d_compute(f32x4 (&o)[4], f32x4& ol, const TileRegs& R, const bf16x8 (&qf)[2], const f32x4 cinit, int kr, int kc0, const LAS float* rpl, LAS char* vt, int lane) {
    tile_v_to_lds(R, vt, lane);
    const LAS float* rr_ = rpl + kr * 31;
    f32x4 st[2];
#pragma unroll
    for (int t = 0; t < 2; ++t) {
        st[t] = MFMA16(k_frag(vt, t, 0, lane), qf[0], cinit); st[t] = MFMA16(k_frag(vt, t, 1, lane), qf[1], st[t]);
#pragma unroll
        for (int i = 0; i < 4; ++i) { const bool ok = (unsigned)(kc0 + 16 * t + i) <= 15u;
            const float v = st[t][i] + rr_[16 * t + i];
            st[t][i] = ok ? v : -1e30f; }
    }
    fb_update(o, ol, st[0], st[1], vt, lane);
    asm volatile("" ::: "memory");
}
DI float d_stage_rpb(const float* rpb_l, int h, LAS char* vt, int lane) {
    LAS float* rp = (LAS float*)(vt + 12288); float rmax = 0.f;
    for (int i = lane; i < 15 * 31; i += 64) { const float v = rpb_l[h * 465 + i] * LOG2E; rp[i] = v; rmax = fmaxf(rmax, fabsf(v)); }
#pragma unroll
    for (int o_ = 1; o_ < 64; o_ <<= 1) rmax = fmaxf(rmax, __shfl_xor(rmax, o_));
    return rmax;
}
DI void mixerD2_unit(int u, const bf16* PROJ, bf16* YC, float rmax, const float* kmax_l, LAS char* vt, int wave, int lane) {
    const int b = u >> 6, h = (u >> 4) & 3, wu = (u & 15) * 8 + wave, rr = wu >> 2, cb = wu & 3, r = lane & 15, g = lane >> 4;
    const bf16* kb = slab(PROJ, C_DK + h * 64, b); const bf16* vb = slab(PROJ, C_DV + h * 64, b);
    const int qcol = 16 * cb + r, tq = 64 * rr + qcol;
    const int cs = min(max(qcol - 8, 0), 48), rs = min(max(rr - 4, 0), 24), c0 = min(max(16 * cb - 8, 0), 32);
    LAS float* rp = (LAS float*)(vt + 12288);
    bf16x8 qf[2];
#pragma unroll
    for (int ks = 0; ks < 2; ++ks) qf[ks] = *(const bf16x8*)(slab(PROJ, C_DQ + h * 64, b) + (size_t)tq * 64 + 32 * ks + 8 * g);
    const float bound = sqrtf(q_norm2(qf) * (kmax_l[b * 128 + 104 + 2 * h] + kmax_l[b * 128 + 105 + 2 * h])) * 1.01f + 0.05f + rmax;
    const f32x4 cinit = {-bound, -bound, -bound, -bound};
    f32x4 o[4], ol = {0.f, 0.f, 0.f, 0.f};
#pragma unroll
    for (int c = 0; c < 4; ++c) o[c] = ol;
    const int tb0 = 64 * rs + c0, dr0 = rs - rr + 7;
    const int kc0 = c0 + 4 * g - cs;
    const LAS float* rpl = rp + dr0 * 31 + (c0 + 4 * g - qcol + 15);
    TileRegs R0, R1, R2;
    tile_load(R0, kb, vb, tb0, 1, lane); tile_load(R1, kb, vb, tb0 + 64, 1, lane); tile_load(R2, kb, vb, tb0 + 128, 1, lane);
    d_compute(o, ol, R0, qf, cinit, 0, kc0, rpl, vt, lane); tile_load(R0, kb, vb, tb0 + 192, 1, lane);
    d_compute(o, ol, R1, qf, cinit, 1, kc0, rpl, vt, lane); tile_load(R1, kb, vb, tb0 + 256, 1, lane);
    d_compute(o, ol, R2, qf, cinit, 2, kc0, rpl, vt, lane); tile_load(R2, kb, vb, tb0 + 320, 1, lane);
    d_compute(o, ol, R0, qf, cinit, 3, kc0, rpl, vt, lane); tile_load(R0, kb, vb, tb0 + 384, 1, lane);
    d_compute(o, ol, R1, qf, cinit, 4, kc0, rpl, vt, lane); tile_load(R1, kb, vb, tb0 + 448, 1, lane);
    d_compute(o, ol, R2, qf, cinit, 5, kc0, rpl, vt, lane);
    d_compute(o, ol, R0, qf, cinit, 6, kc0, rpl, vt, lane);
    d_compute(o, ol, R1, qf, cinit, 7, kc0, rpl, vt, lane);
    const float inv = 1.f / ol[0];
    LAS char* sc = vt + SC_OFF; const int tok0 = 64 * rr + 16 * cb;
    u32x2 gv[4];
    rows16_load(sc, slab(PROJ, C_DG + h * 64, b), 64, tok0, 1, lane);
#pragma unroll
    for (int c = 0; c < 4; ++c) gv[c] = *(const LAS u32x2*)(sc + r * VT_PITCH + (16 * c + 4 * g) * 2);
#pragma unroll
    for (int c = 0; c < 4; ++c) { const f32x4 ov = o[c] * inv;
        u32x2 w; w.x = pk2(ov[0] * silu_f(bflo(gv[c].x)), ov[1] * silu_f(bfhi(gv[c].x))); w.y = pk2(ov[2] * silu_f(bflo(gv[c].y)), ov[3] * silu_f(bfhi(gv[c].y)));
        *(LAS u32x2*)(sc + r * VT_PITCH + (16 * c + 4 * g) * 2) = w; }
    rows16_store(sc, YC + (size_t)b * T * 1024 + 768 + h * 64, 1024, tok0, 1, lane);
}
DI void conv_image(LAS char* img, const bf16* PROJ, int b, int t0, int chan0, const float* cw, const float* cb, int item) {
    const int cgp = item & 15, tg = item >> 4, ch = chan0 + cgp * 8, tb = t0 + tg * 8;
    const bf16* base = slab(PROJ, (C_CX + ch) & ~63, b) + ((C_CX + ch) & 63);
    float w[5][8], o[8][8];
#pragma unroll
    for (int k = 0; k < 5; ++k) { const f32x4 a = *(const f32x4*)(cw + k * 768 + ch), c = *(const f32x4*)(cw + k * 768 + ch + 4);
#pragma unroll
        for (int e = 0; e < 4; ++e) { w[k][e] = a[e]; w[k][4 + e] = c[e]; } }
    { const f32x4 a = *(const f32x4*)(cb + ch), c = *(const f32x4*)(cb + ch + 4);
#pragma unroll
      for (int oi = 0; oi < 8; ++oi)
#pragma unroll
          for (int e = 0; e < 4; ++e) { o[oi][e] = a[e]; o[oi][4 + e] = c[e]; } }
#pragma unroll
    for (int ri = 0; ri < 12; ++ri) {
        const int t = tb - 2 + ri;
        u32x4 v = (u32x4){0u, 0u, 0u, 0u};
        if (t >= 0 && t < T) v = *(const u32x4*)(base + (size_t)t * 64);
        float in[8] = {bflo(v.x), bfhi(v.x), bflo(v.y), bfhi(v.y), bflo(v.z), bfhi(v.z), bflo(v.w), bfhi(v.w)};
#pragma unroll
        for (int k = 0; k < 5; ++k) { const int oi = ri - k;
            if (oi >= 0 && oi < 8) {
#pragma unroll
                for (int e = 0; e < 8; ++e) o[oi][e] += w[k][e] * in[e]; } }
    }
#pragma unroll
    for (int oi = 0; oi < 8; ++oi) { u32x4 pk; pk.x = pk2(silu_f(o[oi][0]), silu_f(o[oi][1])); pk.y = pk2(silu_f(o[oi][2]), silu_f(o[oi][3]));
        pk.z = pk2(silu_f(o[oi][4]), silu_f(o[oi][5])); pk.w = pk2(silu_f(o[oi][6]), silu_f(o[oi][7]));
        *(LAS u32x4*)(img + (tg * 8 + oi) * IMG_PITCH + cgp * 16) = pk; }
}
template <bool AUXW>
DI void decay_tables(LAS float* gtab, LAS float* aux, const float* DT, const float* a_log_l, float* TOT, int b, int c, int grp, int combo, int lane) {
    const int hh = combo >> 1, dir = combo & 1, h = 2 * grp + hh;
    const float A = -__expf(a_log_l[dir * 4 + h]);
    const size_t row = (size_t)b * T + c * 128 + 2 * lane;
    const float dt0 = DT[row * 8 + dir * 4 + h], dt1 = DT[(row + 1) * 8 + dir * 4 + h];
    const float a0 = A * dt0, a1 = A * dt1;
    float s = a0 + a1;
#pragma unroll
    for (int o = 1; o < 64; o <<= 1) { const float v = __shfl_up(s, o); if (lane >= o) s += v; }
    const float tot = __shfl(s, 63);
    float g0, g1;
    if (dir == 0) { g1 = s; g0 = s - a1; } else { g0 = tot - (s - a1) + a0; g1 = tot - s + a1; }
    gtab[combo * 128 + 2 * lane] = g0; gtab[combo * 128 + 2 * lane + 1] = g1;
    if (AUXW) { aux[combo * 128 + 2 * lane] = dt0 * __expf(tot - g0); aux[combo * 128 + 2 * lane + 1] = dt1 * __expf(tot - g1);
        if (lane == 0) TOT[((b * 16 + c) * 4 + h) * 2 + dir] = tot; }
    else { aux[combo * 128 + 2 * lane] = dt0; aux[combo * 128 + 2 * lane + 1] = dt1; }
}
DI void ssd_part1_unit(int u, const bf16* PROJ, float* DT, const bf16* H, const bf16* wdtb_l, const float* dt_bias_l, const float* cw, const float* cb, const float* a_log_l, float* STATES, float* TOT,
                       LAS unsigned char* ldsu, int tid, int wave, int lane) {
    const int b = u >> 5, c = (u >> 1) & 15, grp = u & 1, t0 = c * 128;
    LAS char* lds = (LAS char*)ldsu;
    LAS char* XS = lds; LAS char* BM = lds + IMG_BYTES;
    LAS float* gtab = (LAS float*)(lds + 3 * IMG_BYTES); LAS float* wtab = gtab + 512;
    const int r = lane & 15, g = lane >> 4, q = (lane & 15) >> 2, p = lane & 3;
    __syncthreads();
    {
        LAS char* wl = lds + 3 * IMG_BYTES + 4096;
        LAS char* hst = lds + 2 * IMG_BYTES + wave * (16 * IMG_PITCH);
        for (int i = tid; i < 1024; i += 512) { const int row = i >> 7, ch = i & 127; *(LAS u32x4*)(wl + row * 2064 + ch * 16) = *(const u32x4*)(wdtb_l + (size_t)row * 1024 + ch * 8); }
        __syncthreads();
        f32x4 dacc = {0.f, 0.f, 0.f, 0.f};
        const bf16* hrow = H + (size_t)(b * T + t0 + 16 * wave) * 1024;
        u32x4 hv[4];
#pragma unroll
        for (int it = 0; it < 4; ++it) { const int n = lane + 64 * it; hv[it] = __builtin_nontemporal_load((const u32x4*)(hrow + (size_t)(n >> 4) * 1024 + (n & 15) * 8)); }
        for (int ck = 0; ck < 8; ++ck) {
#pragma unroll
            for (int it = 0; it < 4; ++it) { const int n = lane + 64 * it; *(LAS u32x4*)(hst + (n >> 4) * IMG_PITCH + (n & 15) * 16) = hv[it]; }
            if (ck + 1 < 8) {
#pragma unroll
                for (int it = 0; it < 4; ++it) { const int n = lane + 64 * it; hv[it] = __builtin_nontemporal_load((const u32x4*)(hrow + (size_t)(n >> 4) * 1024 + (ck + 1) * 128 + (n & 15) * 8)); } }
#pragma unroll
            for (int ks = 0; ks < 4; ++ks) {
                const bf16x8 af = *(const LAS bf16x8*)(hst + r * IMG_PITCH + 64 * ks + 16 * g);
                bf16x8 bfw = {0, 0, 0, 0, 0, 0, 0, 0};
                if (r < 8) bfw = *(const LAS bf16x8*)(wl + r * 2064 + (ck * 128 + 32 * ks + 8 * g) * 2);
                dacc = MFMA16(af, bfw, dacc);
            }
            asm volatile("" ::: "memory");
        }
        if (r < 8) { const float bias = dt_bias_l[r];
#pragma unroll
            for (int i = 0; i < 4; ++i) { const float xx = dacc[i] + bias; DT[(size_t)(b * T + t0 + 16 * wave + 4 * g + i) * 8 + r] = xx > 20.f ? xx : log1pf(__expf(xx)); } }
    }
    __syncthreads();
    { const int img = tid >> 8; conv_image(img ? BM : XS, PROJ, b, t0, img ? 256 + grp * 128 : grp * 128, cw, cb, tid & 255); }
    asm volatile("s_waitcnt vmcnt(0)" ::: "memory");
    __syncthreads();
    if (wave < 4) decay_tables<true>(gtab, wtab, DT, a_log_l, TOT, b, c, grp, wave, lane);
    __syncthreads();
    bf16x8 bfr[4];
#pragma unroll
    for (int ks = 0; ks < 4; ++ks) { const LAS char* bp = BM + (32 * ks + 8 * g + q) * IMG_PITCH + 32 * wave + 8 * p; bfr[ks] = cat8(vtr(bp), vtr(bp + 4 * IMG_PITCH)); }
#pragma unroll
    for (int combo = 0; combo < 4; ++combo) {
        const int hh = combo >> 1, dir = combo & 1, h = 2 * grp + hh;
        f32x4 acc[4];
#pragma unroll
        for (int pt = 0; pt < 4; ++pt) acc[pt] = (f32x4){0.f, 0.f, 0.f, 0.f};
#pragma unroll
        for (int ks = 0; ks < 4; ++ks) {
            const f32x4 w0 = *(const LAS f32x4*)(wtab + combo * 128 + 32 * ks + 8 * g), w1 = *(const LAS f32x4*)(wtab + combo * 128 + 32 * ks + 8 * g + 4);
#pragma unroll
            for (int pt = 0; pt < 4; ++pt) {
                const LAS char* xp = XS + (32 * ks + 8 * g + q) * IMG_PITCH + (hh * 64 + 16 * pt) * 2 + 8 * p;
                const u32x2 lo = __builtin_bit_cast(u32x2, vtr(xp)), hi = __builtin_bit_cast(u32x2, vtr(xp + 4 * IMG_PITCH));
                u32x4 af; af.x = pk2(bflo(lo.x) * w0[0], bfhi(lo.x) * w0[1]); af.y = pk2(bflo(lo.y) * w0[2], bfhi(lo.y) * w0[3]);
                af.z = pk2(bflo(hi.x) * w1[0], bfhi(hi.x) * w1[1]); af.w = pk2(bflo(hi.y) * w1[2], bfhi(hi.y) * w1[3]);
                acc[pt] = MFMA16(__builtin_bit_cast(bf16x8, af), bfr[ks], acc[pt]);
            }
        }
        float* sb = STATES + ((size_t)(((b * 16 + c) * 4 + h) * 2 + dir) * 64) * 128;
#pragma unroll
        for (int pt = 0; pt < 4; ++pt)
#pragma unroll
            for (int i = 0; i < 4; ++i) sb[(size_t)(16 * pt + 4 * g + i) * 128 + 16 * wave + r] = acc[pt][i];
    }
}
DI void ssd_scan(float* STATES, const float* TOT, int gtid, int gthreads) {
    for (int it = gtid; it < 8 * 4 * 2 * 64 * 32; it += gthreads) {
        const int n4 = it & 31, p = (it >> 5) & 63, dir = (it >> 11) & 1, h = (it >> 12) & 3, b = it >> 14;
        f32x4 v[16]; float e[16];
#pragma unroll
        for (int st = 0; st < 16; ++st) { const int c = dir ? 15 - st : st; const int hd = ((b * 16 + c) * 4 + h) * 2 + dir;
            v[st] = *(const f32x4*)(STATES + ((size_t)hd * 64 + p) * 128 + n4 * 4); e[st] = __expf(TOT[hd]); }
        f32x4 carry = (f32x4){0.f, 0.f, 0.f, 0.f};
#pragma unroll
        for (int st = 0; st < 16; ++st) { const int c = dir ? 15 - st : st; const int hd = ((b * 16 + c) * 4 + h) * 2 + dir;
            *(f32x4*)(STATES + ((size_t)hd * 64 + p) * 128 + n4 * 4) = carry; carry = carry * e[st] + v[st]; }
    }
}
DI void ssd_part2_unit(int u, const bf16* PROJ, const float* DT, const float* cw, const float* cb, const float* a_log_l, const float* dskip_l, const float* snw_l,
                       const float* STATES, bf16* YC, LAS unsigned char* ldsu, int tid, int wave, int lane) {
    const int b = u >> 5, c = (u >> 1) & 15, grp = u & 1, t0 = c * 128;
    LAS char* lds = (LAS char*)ldsu;
    LAS char* XS = lds; LAS char* BM = lds + IMG_BYTES; LAS char* CM = lds + 2 * IMG_BYTES;
    LAS float* gtab = (LAS float*)(lds + 3 * IMG_BYTES); LAS float* dttab = gtab + 512;
    __syncthreads();
    if (tid < 256) conv_image(CM, PROJ, b, t0, 512 + grp * 128, cw, cb, tid);
    if (wave >= 4) decay_tables<false>(gtab, dttab, DT, a_log_l, nullptr, b, c, grp, wave - 4, lane);
#pragma unroll 4
    for (int k = 0; k < 16; ++k) { const int idx = tid + 512 * k, combo = idx >> 11, within = idx & 2047, pp = within >> 5, n4 = within & 31;
        const int hh = combo >> 1, dir = combo & 1, h = 2 * grp + hh;
        const f32x4 sv = *(const f32x4*)(STATES + ((size_t)(((b * 16 + c) * 4 + h) * 2 + dir) * 64 + pp) * 128 + n4 * 4);
        u32x2 w; w.x = pk2(sv[0], sv[1]); w.y = pk2(sv[2], sv[3]);
        *(LAS u32x2*)(lds + combo * (64 * IMG_PITCH) + pp * IMG_PITCH + n4 * 8) = w; }
    __syncthreads();
    const int r = lane & 15, g = lane >> 4, q = (lane & 15) >> 2, p = lane & 3;
    const int l0 = 16 * wave, lq = l0 + r;
    bf16x8 cq[4];
#pragma unroll
    for (int ks = 0; ks < 4; ++ks) cq[ks] = *(const LAS bf16x8*)(CM + lq * IMG_PITCH + 64 * ks + 16 * g);
    f32x4 acc[2][4];
#pragma unroll
    for (int hh = 0; hh < 2; ++hh)
#pragma unroll
        for (int pt = 0; pt < 4; ++pt) acc[hh][pt] = (f32x4){0.f, 0.f, 0.f, 0.f};
#pragma unroll
    for (int combo = 0; combo < 4; ++combo) {
        const int hh = combo >> 1;
        const float eg = __expf(gtab[combo * 128 + lq]);
#pragma unroll
        for (int pt = 0; pt < 4; ++pt) {
            f32x4 tmp = (f32x4){0.f, 0.f, 0.f, 0.f};
#pragma unroll
            for (int ks = 0; ks < 4; ++ks) { const bf16x8 af = *(const LAS bf16x8*)(lds + combo * (64 * IMG_PITCH) + (16 * pt + r) * IMG_PITCH + 64 * ks + 16 * g); tmp = MFMA16(af, cq[ks], tmp); }
            acc[hh][pt] += tmp * eg;
        }
    }
    __syncthreads();
    { const int img = tid >> 8; conv_image(lds + img * IMG_BYTES, PROJ, b, t0, img * 256 + grp * 128, cw, cb, tid & 255); }
    __syncthreads();
    for (int st = 0; st < 4; ++st) {
        f32x4 gt[2];
#pragma unroll
        for (int t = 0; t < 2; ++t) { gt[t] = (f32x4){0.f, 0.f, 0.f, 0.f};
#pragma unroll
            for (int ks = 0; ks < 4; ++ks) { const bf16x8 bf = *(const LAS bf16x8*)(BM + (32 * st + 16 * t + r) * IMG_PITCH + 64 * ks + 16 * g); gt[t] = MFMA16(bf, cq[ks], gt[t]); } }
#pragma unroll
        for (int combo = 0; combo < 4; ++combo) {
            const int hh = combo >> 1, dir = combo & 1;
            const bool need = dir == 0 ? (32 * st <= l0 + 15) : (32 * st + 31 >= l0);
            if (need) {
                const float gl = gtab[combo * 128 + lq];
                f32x4 mm[2];
#pragma unroll
                for (int t = 0; t < 2; ++t) { const int sbase = 32 * st + 16 * t + 4 * g;
                    const f32x4 gs = *(const LAS f32x4*)(gtab + combo * 128 + sbase), ds = *(const LAS f32x4*)(dttab + combo * 128 + sbase);
#pragma unroll
                    for (int i = 0; i < 4; ++i) { const int se = sbase + i; const bool ok = dir == 0 ? (se <= lq) : (se >= lq);
                        const float e = __expf(fminf(gl - gs[i], 0.f)); mm[t][i] = ok ? gt[t][i] * e * ds[i] : 0.f; } }
                const bf16x8 pf = pack8(mm[0], mm[1]);
#pragma unroll
                for (int pt = 0; pt < 4; ++pt) { const LAS char* xp = XS + (32 * st + 4 * g + q) * IMG_PITCH + (hh * 64 + 16 * pt) * 2 + 8 * p;
                    acc[hh][pt] = MFMA16(cat8(vtr(xp), vtr(xp + 16 * IMG_PITCH)), pf, acc[hh][pt]); }
            }
        }
    }
    const int token = t0 + lq; float ss = 0.f;
#pragma unroll
    for (int hh = 0; hh < 2; ++hh) { const float dsk = dskip_l[2 * grp + hh];
#pragma unroll
        for (int pt = 0; pt < 4; ++pt) { const int ch = hh * 64 + 16 * pt + 4 * g;
            const u32x2 xv = *(const LAS u32x2*)(XS + lq * IMG_PITCH + ch * 2);
            const u32x2 zv = *(const u32x2*)(slab(PROJ, C_CZ + grp * 128 + hh * 64, b) + (size_t)token * 64 + 16 * pt + 4 * g);
            f32x4 y = acc[hh][pt];
            y[0] = (y[0] + dsk * bflo(xv.x)) * silu_f(bflo(zv.x)); y[1] = (y[1] + dsk * bfhi(xv.x)) * silu_f(bfhi(zv.x));
            y[2] = (y[2] + dsk * bflo(xv.y)) * silu_f(bflo(zv.y)); y[3] = (y[3] + dsk * bfhi(xv.y)) * silu_f(bfhi(zv.y));
            acc[hh][pt] = y; ss += (y[0] * y[0] + y[1] * y[1]) + (y[2] * y[2] + y[3] * y[3]); } }
    ss += __shfl_xor(ss, 16); ss += __shfl_xor(ss, 32);
    const float rstd = rsqrtf(ss * (1.f / 128.f) + EPS);
#pragma unroll
    for (int hh = 0; hh < 2; ++hh)
#pragma unroll
        for (int pt = 0; pt < 4; ++pt) { const int ch = grp * 128 + hh * 64 + 16 * pt + 4 * g;
            const f32x4 nw = *(const f32x4*)(snw_l + ch); const f32x4 y = acc[hh][pt] * rstd * nw;
            u32x2 w; w.x = pk2(y[0], y[1]); w.y = pk2(y[2], y[3]);
            *(u32x2*)(YC + (size_t)(b * T + token) * 1024 + 512 + ch) = w; }
}

DI void phase_final(float* xo, const float* fw, int tid, int G) {
    const int lane = tid & 63, wave = tid >> 6;
    f32x4 nw[4];
#pragma unroll
    for (int j = 0; j < 4; ++j) nw[j] = *(const f32x4*)(fw + 4 * lane + 256 * j);
    const int stride = G * 8, nrow = (M - (blockIdx.x * 8 + wave) + stride - 1) / stride;
    const int row0 = blockIdx.x * 8 + wave;
    f32x4 vb[3][4];
#pragma unroll
    for (int pre = 0; pre < 2; ++pre) if (pre < nrow) { const f32x4* xr = (const f32x4*)(xo + (size_t)(row0 + pre * stride) * 1024) + lane;
#pragma unroll
        for (int j = 0; j < 4; ++j) vb[pre][j] = xr[64 * j]; }
    for (int it0 = 0; it0 < nrow; it0 += 3) {
#pragma unroll
        for (int k = 0; k < 3; ++k) { const int it = it0 + k;
            if (it < nrow) {
                if (it + 2 < nrow) { const f32x4* xn = (const f32x4*)(xo + (size_t)(row0 + (it + 2) * stride) * 1024) + lane;
#pragma unroll
                    for (int j = 0; j < 4; ++j) vb[(k + 2) % 3][j] = xn[64 * j]; }
                f32x4* xr = (f32x4*)(xo + (size_t)(row0 + it * stride) * 1024) + lane;
                f32x4 v[4]; float ss = 0.f;
#pragma unroll
                for (int j = 0; j < 4; ++j) { v[j] = vb[k][j]; ss += (v[j][0] * v[j][0] + v[j][1] * v[j][1]) + (v[j][2] * v[j][2] + v[j][3] * v[j][3]); }
                const float rstd = rsqrtf(wave_sum(ss) * (1.f / 1024.f) + EPS);
#pragma unroll
                for (int j = 0; j < 4; ++j) xr[64 * j] = v[j] * rstd * nw[j];
            } }
    }
}

#ifndef EN_P0
#define EN_P0 1
#endif
#ifndef EN_P1
#define EN_P1 1
#endif
#ifndef EN_G1
#define EN_G1 1
#endif
#ifndef EN_B
#define EN_B 1
#endif
#ifndef EN_S1
#define EN_S1 1
#endif
#ifndef EN_A
#define EN_A 1
#endif
#ifndef EN_D
#define EN_D 1
#endif
#ifndef EN_SCAN
#define EN_SCAN 1
#endif
#ifndef EN_S2
#define EN_S2 1
#endif
#ifndef EN_G2
#define EN_G2 1
#endif
#ifndef EN_FIN
#define EN_FIN 1
#endif
#define XB_TMO      128
#define XB_XCNT(j)  (256  + 64 * (j))
#define XB_XSUB(j)  (1280 + 64 * (j))
#define XB_XGEN(j)  (2304 + 64 * (j))
#define XB_TOP      3328
#define XB_TOPGEN   3392
#define XCD_BAR_WORDS 3456
#define XB_SPIN_CAP (1u << 18)

__device__ __forceinline__ unsigned xb_ld(unsigned* p)              { return __hip_atomic_load(p, __ATOMIC_RELAXED, __HIP_MEMORY_SCOPE_AGENT); }
__device__ __forceinline__ unsigned xb_add(unsigned* p, unsigned v) { return __hip_atomic_fetch_add(p, v, __ATOMIC_RELAXED, __HIP_MEMORY_SCOPE_AGENT); }
__device__ __forceinline__ unsigned xb_xcc_id() { return (unsigned)__builtin_amdgcn_s_getreg((3 << 11) | 20) & 0xFu; }
#define XB_SPIN(cond, bar) do { unsigned _sp = 0; while (cond) { __builtin_amdgcn_s_sleep(1); \
    if ((++_sp & 255u) == 0u) { if (xb_ld(&(bar)[XB_TMO])) break; if (_sp > XB_SPIN_CAP) { atomicAdd(&(bar)[XB_TMO], 1u); break; } } } } while (0)

struct XcdBarrier {
    unsigned* bar; unsigned x;
    volatile LAS unsigned* st;
};

__device__ __forceinline__ XcdBarrier xcd_barrier_post(unsigned* bar, volatile LAS unsigned* st) {
    XcdBarrier b; b.bar = bar; b.x = xb_xcc_id(); b.st = st;
    if (threadIdx.x == 0) (void)xb_add(&bar[XB_XCNT(b.x)], 1u);
    return b;
}
__device__ __forceinline__ void xcd_barrier_complete(unsigned* bar, unsigned x, unsigned& nloc, unsigned& nx) {
    const unsigned G = gridDim.x * gridDim.y * gridDim.z;
    unsigned sum, cnt, mine, sp = 0u;
    for (;;) {
        sum = 0u; cnt = 0u; mine = 0u;
#pragma unroll
        for (unsigned j = 0; j < 16; ++j) { const unsigned c = xb_ld(&bar[XB_XCNT(j)]); sum += c; cnt += (c > 0u) ? 1u : 0u; mine = (j == x) ? c : mine; }
        if (sum == G) break;
        __builtin_amdgcn_s_sleep(1);
        if ((++sp & 255u) == 0u) { if (xb_ld(&bar[XB_TMO])) break; if (sp > XB_SPIN_CAP) { atomicAdd(&bar[XB_TMO], 1u); break; } }
    }
    nloc = mine > 0u ? mine : 1u; nx = cnt > 0u ? cnt : 1u;
}

__device__ __forceinline__ void xcd_barrier(const XcdBarrier& b) {
    asm volatile("s_waitcnt vmcnt(0)" ::: "memory");
    __syncthreads();
    if (threadIdx.x == 0) {
        unsigned* bar = b.bar;
        __builtin_amdgcn_s_waitcnt(0);
        unsigned nloc = b.st[0], nx = b.st[1];
        if (nloc == 0u) { xcd_barrier_complete(bar, b.x, nloc, nx); b.st[0] = nloc; b.st[1] = nx; }
        const unsigned old = xb_add(&bar[XB_XSUB(b.x)], 1u);
        const unsigned gen = old / nloc;
        if (old + 1u == (gen + 1u) * nloc) {
            __builtin_amdgcn_fence(__ATOMIC_RELEASE, "agent");
            asm volatile("s_waitcnt vmcnt(0)" ::: "memory");
            const unsigned og = xb_add(&bar[XB_TOP], 1u);
            const unsigned tg = og / nx;
            if (og + 1u == (tg + 1u) * nx) xb_add(&bar[XB_TOPGEN], 1u);
            else XB_SPIN(xb_ld(&bar[XB_TOPGEN]) == tg, bar);
            __builtin_amdgcn_fence(__ATOMIC_ACQUIRE, "agent");
            xb_add(&bar[XB_XGEN(b.x)], 1u);
            asm volatile("s_waitcnt vmcnt(0)" ::: "memory");
        } else {
            XB_SPIN(xb_ld(&bar[XB_XGEN(b.x)]) == gen, bar);
            __builtin_amdgcn_fence(__ATOMIC_ACQUIRE, "agent");
            asm volatile("s_waitcnt vmcnt(0)" ::: "memory");
        }
    }
    __syncthreads();
}

DI int hw_lane() { int l_; asm volatile("v_mbcnt_lo_u32_b32 %0, -1, 0\n\tv_mbcnt_hi_u32_b32 %0, -1, %0" : "=v"(l_)); return l_; }
struct Args { const float* in[17]; float* out; unsigned char* ws; int ph_lo, ph_hi; };
__global__ void __launch_bounds__(512) fwd_kernel(Args a) {
    extern __shared__ __attribute__((aligned(16))) unsigned char lds_raw[];
    cg::grid_group grid = cg::this_grid();
    LAS unsigned char* lds = (LAS unsigned char*)lds_raw;
    const int wave0 = __builtin_amdgcn_readfirstlane(threadIdx.x >> 6), G = gridDim.x;
#define TID0() (wave0 * 64 + hw_lane())
    const int lo = a.ph_lo, hi = a.ph_hi;
    if (hi > 1000) grid.sync();
    volatile LAS unsigned* bst = (volatile LAS unsigned*)(lds + 131072);
    if (TID0() < 16) bst[TID0()] = 0u;
    __syncthreads();
    XcdBarrier bar = xcd_barrier_post((unsigned*)(a.ws + WS_BAR), bst);
    unsigned char* ws = a.ws;
    bf16* WIN = (bf16*)(ws + WS_WIN); bf16* WOUT = (bf16*)(ws + WS_WOUT); float* MODP = (float*)(ws + WS_MODP); float* DT = (float*)(ws + WS_DT);
    float* TOT = (float*)(ws + WS_TOT); float* KMAX = (float*)(ws + WS_KMAX); bf16* WDT = (bf16*)(ws + WS_WDT); float* MODF = (float*)(ws + WS_MODF); float* LPA = (float*)(ws + WS_LPA); bf16* H = (bf16*)(ws + WS_H); bf16* YC = (bf16*)(ws + WS_YC); bf16* PROJ = (bf16*)(ws + WS_PROJ); float* STATES = (float*)(ws + WS_ST);
#define IN(k) (lo <= (k) && (k) < hi)
#define LAUNDER() int tp = TID0(); const int tid = tp, lane = tp & 63, wave = __builtin_amdgcn_readfirstlane(tp >> 6); (void)tid; (void)lane; (void)wave
#define SEAM(k) do { if (lo <= (k) && (k) + 1 < hi) { XcdBarrier b2_ = bar; asm volatile("" : "+s"(b2_.bar)); xcd_barrier(b2_); } } while (0)
    if (IN(0) && EN_P0) { LAUNDER(); phase0(a.in[1], a.in[3], a.in[5], a.in[15], WIN, WOUT, MODP, KMAX, WDT, lds, tid, G); }
    SEAM(0);
    for (int l = 0; l < 2; ++l) {
        const int pb = 1 + 6 * l;
        const float* modp = MODP + (size_t)l * 8 * 8 * 3072; const float* adab = a.in[4] + l * 3072;
        const float* xin = l == 0 ? a.in[0] : a.out;
        const bool fusedp = (G == 256);
        if (!(l == 1 && fusedp)) { if (IN(pb) && EN_P1) { LAUNDER(); phase_modulate(xin, a.in[2] + l * 1024, modp, adab, H, lds, tid, G, l == 0 ? MODF : nullptr, MODP, a.in[4]); }
            SEAM(pb); }
        if (IN(pb + 1) && EN_G1) { LAUNDER();
            pg8::Gemm g{H, WIN + (size_t)l * NP * 1024, M, NP, 1024}; pg8::StaticOrder S; S.init(M, NP, G, (int)blockIdx.x);
            pg8::EpiProj E{PROJ, (unsigned*)(KMAX + l * 1024), lds + 131072 + 1024};
            pg8::gemm_phase<pg8::EpiProj, pg8::StaticOrder, true, true>(lds, g, S, E, tp);
        }
        SEAM(pb + 1);
        if (IN(pb + 2)) {
            if (EN_B) { LAUNDER(); LAS char* vt = (LAS char*)lds + wave * 16384;
                (void)vt; for (int u = blockIdx.x; u < 256; u += G) { mixerB2_unit(u, l, PROJ, YC, a.in[6] + l * 128, a.in[7] + l * 64, KMAX + l * 1024, (LAS char*)lds, tid, wave, lane); } __syncthreads(); }
            if (EN_S1) { LAUNDER(); __syncthreads();
                for (int u = blockIdx.x; u < 256; u += G) ssd_part1_unit(u, PROJ, DT, H, WDT + l * 16384, a.in[11] + l * 8, a.in[8] + l * 5 * 768, a.in[9] + l * 768, a.in[10] + l * 8, STATES, TOT, lds, tid, wave, lane);
                __syncthreads(); }
            if (EN_A) { LAUNDER(); LAS char* vt = (LAS char*)lds + wave * 16384;
                for (int u = blockIdx.x; u < 512; u += G) { mixerA1_unit(u, PROJ, YC, LPA, KMAX + l * 1024, vt, wave, lane); } }
            if (EN_D) { LAUNDER(); LAS char* vt = (LAS char*)lds + wave * 16384;
                int hcur = -1; float rmax = 0.f;
                for (int u = blockIdx.x; u < 512; u += G) { const int hd = (u >> 4) & 3; if (hd != hcur) { rmax = d_stage_rpb(a.in[14] + l * 4 * 15 * 31, hd, vt, lane); hcur = hd; }
                    mixerD2_unit(u, PROJ, YC, rmax, KMAX + l * 1024, vt, wave, lane); } }
        }
        SEAM(pb + 2);
        if (IN(pb + 3) && EN_SCAN) { LAUNDER(); ssd_scan(STATES, TOT, blockIdx.x * 512 + tid, G * 512); }
        if (IN(pb + 3) && EN_A) { LAUNDER(); LAS char* vt = (LAS char*)lds + wave * 16384;
            for (int u = blockIdx.x; u < 512; u += G) { mixerA2_unit(u, PROJ, YC, LPA, KMAX + l * 1024, vt, wave, lane); } }
        SEAM(pb + 3);
        if (IN(pb + 4) && EN_S2) { LAUNDER();
            for (int u = blockIdx.x; u < 256; u += G)
                ssd_part2_unit(u, PROJ, DT, a.in[8] + l * 5 * 768, a.in[9] + l * 768, a.in[10] + l * 8, a.in[12] + l * 4, a.in[13] + l * 256, STATES, YC, lds, tid, wave, lane);
            __syncthreads();
        }
        SEAM(pb + 4);
        if (IN(pb + 5) && EN_G2) { LAUNDER();
            pg8::Gemm g{YC, WOUT + (size_t)l * 1024 * 1024, M, 1024, 1024}; pg8::StaticOrder S; S.init(M, 1024, G, (int)blockIdx.x);
            if (l == 1 && fusedp) {
                pg8::EpiOutFin E{xin, a.out, MODF + (size_t)l * 24576, a.in[16], (float*)(ws + WS_XCH2), (unsigned*)(ws + WS_BAR + 16384) + 32};
                pg8::gemm_phase<pg8::EpiOutFin, pg8::StaticOrder, true, true>(lds, g, S, E, tp);
            } else if (fusedp) {
                pg8::EpiOutMod E{xin, a.out, MODF, a.in[2] + 1024, MODF + 24576, H, (float*)(ws + WS_XCH), (unsigned*)(ws + WS_BAR + 16384)};
                pg8::gemm_phase<pg8::EpiOutMod, pg8::StaticOrder, true, true>(lds, g, S, E, tp);
            } else {
                pg8::EpiOut E{xin, a.out, MODF + (size_t)l * 24576};
                pg8::gemm_phase<pg8::EpiOut, pg8::StaticOrder, true, true>(lds, g, S, E, tp);
            }
        }
        if (!(l == 1 && fusedp)) SEAM(pb + 5);
    }
    if (IN(13) && EN_FIN && G != 256) { LAUNDER(); phase_final(a.out, a.in[16], tid, G); }
#undef IN
#undef SEAM
}

extern "C" void kernel_launch(void* const* d_in, const int* in_sizes, int n_in, void* d_out, int out_size, void* d_ws, size_t ws_size, hipStream_t stream) {
    static int grid = 0;
    if (grid == 0) {
        int dev = 0, cus = 0, per_cu = 0;
        hipGetDevice(&dev);
        hipDeviceGetAttribute(&cus, hipDeviceAttributeMultiprocessorCount, dev);
        hipFuncSetAttribute((const void*)fwd_kernel, hipFuncAttributeMaxDynamicSharedMemorySize, LDS_BYTES);
        hipOccupancyMaxActiveBlocksPerMultiprocessor(&per_cu, (const void*)fwd_kernel, 512, LDS_BYTES);
        if (per_cu < 1) per_cu = 1;
        grid = cus * per_cu;
        if (ws_size < WS_END) fprintf(stderr, "kernel_launch: workspace too small: %zu < %zu\n", ws_size, (size_t)WS_END);
        (void)hipGetLastError();
    }
    Args a{};
    for (int i = 0; i < 17; ++i) a.in[i] = (const float*)d_in[i];
    a.out = (float*)d_out; a.ws = (unsigned char*)d_ws; a.ph_lo = 0; a.ph_hi = 14;
    void* args[] = {&a};
    (void)hipMemsetAsync((char*)d_ws + WS_BAR, 0, 32768, stream);
    hipError_t e = hipLaunchCooperativeKernel((const void*)fwd_kernel, dim3(grid), dim3(512), args, LDS_BYTES, stream);
    if (e != hipSuccess) fprintf(stderr, "cooperative launch failed: %s (grid %d)\n", hipGetErrorString(e), grid);
}
```
